# Optimizing an MI355X kernel written in HIP

```python
import jax, jax.numpy as jnp
from jax import lax
import numpy as np

D_MODEL = 2048
BATCH = 8
SEQ = 2048
DEPTH = 1

MIX_WIDTH = D_MODEL
CONV_WIDTH = MIX_WIDTH // 2
CONV_GROUPS = 8
CONV_K = 3
FOX_WIDTH = MIX_WIDTH - CONV_WIDTH
HEAD_DIM = 128
FOX_HEADS = FOX_WIDTH // HEAD_DIM
Q_BLOCK = 128
MIX_IN = 3 * CONV_WIDTH + 3 * FOX_WIDTH + FOX_HEADS
MEM_TOKENS = 256
XATTN_HEADS = 4
XATTN_WIDTH = XATTN_HEADS * HEAD_DIM
N_EXPERTS = 32
TOP_K = 4
D_FF = D_MODEL
SWIGLU_LIMIT = 7.0
SWIGLU_ALPHA = 1.702
MOE_BLOCK = 128
EPS = 1e-6

kernel_name = "hybrid_conv_fox_memxattn_moe"


def rms_norm(x, g):
    xf = x.astype(jnp.float32)
    y = xf * lax.rsqrt(jnp.mean(xf * xf, axis=-1, keepdims=True) + EPS)
    return (y * g.astype(jnp.float32)).astype(x.dtype)


def causal_dwconv(u, w):
    c = u.shape[-1]
    return lax.conv_general_dilated(
        u, w[:, None, :].astype(u.dtype), window_strides=(1,),
        padding=[(CONV_K - 1, 0)], dimension_numbers=("NWC", "WIO", "NWC"),
        feature_group_count=c)


def fox_attention(q, k, v, log_f):
    b, s, h, dh = q.shape
    scale = dh ** -0.5
    c = jnp.cumsum(log_f, axis=1).transpose(0, 2, 1)
    nb = s // Q_BLOCK
    qb = q.reshape(b, nb, Q_BLOCK, h, dh).transpose(1, 0, 2, 3, 4)
    cq = c.reshape(b, h, nb, Q_BLOCK).transpose(2, 0, 1, 3)
    pos_k = jnp.arange(s)

    def one_block(args):
        qi, ci, bi = args
        pos_q = bi * Q_BLOCK + jnp.arange(Q_BLOCK)
        sc = jnp.einsum("bqhd,bkhd->bhqk", qi, k).astype(jnp.float32) * scale
        sc = sc + (ci[..., :, None] - c[..., None, :])
        mask = pos_k[None, :] <= pos_q[:, None]
        sc = jnp.where(mask, sc, jnp.finfo(jnp.float32).min)
        p = jax.nn.softmax(sc, axis=-1).astype(v.dtype)
        return jnp.einsum("bhqk,bkhd->bqhd", p, v)

    out = lax.map(one_block, (qb, cq, jnp.arange(nb)))
    return out.transpose(1, 0, 2, 3, 4).reshape(b, s, h * dh)


def memory_cross_attention(h, hm, w_q, w_kv, g_q, g_k, w_o):
    b, s, _ = h.shape
    m = hm.shape[1]
    q = (h @ w_q).reshape(b, s, XATTN_HEADS, HEAD_DIM)
    k, v = jnp.split(hm @ w_kv, 2, axis=-1)
    k = k.reshape(b, m, XATTN_HEADS, HEAD_DIM)
    v = v.reshape(b, m, XATTN_HEADS, HEAD_DIM)
    q = rms_norm(q, g_q)
    k = rms_norm(k, g_k)
    sc = jnp.einsum("bqhd,bkhd->bhqk", q, k).astype(jnp.float32) * HEAD_DIM ** -0.5
    p = jax.nn.softmax(sc, axis=-1).astype(v.dtype)
    o = jnp.einsum("bhqk,bkhd->bqhd", p, v).reshape(b, s, XATTN_WIDTH)
    return o @ w_o


def clamped_swiglu_expert(xb, w_gu, b_gu, w_dn, b_dn):
    gu = xb @ w_gu + b_gu
    gate, up = jnp.split(gu, 2, axis=-1)
    gate = jnp.minimum(gate, SWIGLU_LIMIT)
    up = jnp.clip(up, -SWIGLU_LIMIT, SWIGLU_LIMIT)
    glu = gate * jax.nn.sigmoid(SWIGLU_ALPHA * gate)
    return ((up + 1.0) * glu) @ w_dn + b_dn


def moe(h, w_router, b_router, w_gate_up, b_gate_up, w_down, b_down):
    t, d = h.shape
    logits = h.astype(jnp.float32) @ w_router.astype(jnp.float32) + b_router.astype(jnp.float32)
    top_val, top_idx = lax.top_k(logits, TOP_K)
    gates = jax.nn.softmax(top_val, axis=-1)
    n_assign = t * TOP_K
    flat_e = top_idx.reshape(-1)
    order = jnp.argsort(flat_e)
    sorted_e = flat_e[order]
    tok = order // TOP_K
    counts = jnp.bincount(flat_e, length=N_EXPERTS)
    padded = (counts + MOE_BLOCK - 1) // MOE_BLOCK * MOE_BLOCK
    pad_end = jnp.cumsum(padded)
    pad_start = pad_end - padded
    start = jnp.cumsum(counts) - counts
    dest = pad_start[sorted_e] + (jnp.arange(n_assign) - start[sorted_e])
    n_blocks = -(-n_assign // MOE_BLOCK) + N_EXPERTS
    n_rows = n_blocks * MOE_BLOCK
    row_tok = jnp.zeros((n_rows,), jnp.int32).at[dest].set(tok.astype(jnp.int32))
    row_gate = jnp.zeros((n_rows,), h.dtype).at[dest].set(gates.reshape(-1)[order].astype(h.dtype))
    block_start = jnp.arange(n_blocks) * MOE_BLOCK
    block_expert = jnp.minimum(jnp.searchsorted(pad_end, block_start, side="right"), N_EXPERTS - 1)
    xs = h[row_tok].reshape(n_blocks, MOE_BLOCK, d)

    def expert_block(args):
        xb, e = args
        return clamped_swiglu_expert(xb, w_gate_up[e], b_gate_up[e], w_down[e], b_down[e])

    ys = lax.map(expert_block, (xs, block_expert)).reshape(n_rows, d)
    return jnp.zeros((t, d), h.dtype).at[row_tok].add(ys * row_gate[:, None])


def setup_inputs(seed: int = 0) -> dict:
    key = jax.random.key(seed)
    ks = jax.random.split(key, 26)
    f32 = jnp.float32
    L = DEPTH

    def nrm(k, shape, scale):
        return jax.random.normal(k, shape, f32) * scale

    def gain(k, shape):
        return 1.0 + 0.05 * jax.random.normal(k, shape, f32)

    return {
        "x": nrm(ks[0], (BATCH, SEQ, D_MODEL), 1.0),
        "mem": nrm(ks[1], (BATCH, MEM_TOKENS, D_MODEL), 1.0),
        "g_mix": gain(ks[2], (L, D_MODEL)),
        "w_mix_in": nrm(ks[3], (L, D_MODEL, MIX_IN), D_MODEL ** -0.5),
        "b_forget": jax.random.uniform(ks[4], (L, FOX_HEADS), f32, 1.0, 5.0),
        "conv_w": nrm(ks[5], (L, CONV_K, CONV_WIDTH), CONV_K ** -0.5),
        "g_q": gain(ks[6], (L, HEAD_DIM)),
        "g_k": gain(ks[7], (L, HEAD_DIM)),
        "g_conv_out": gain(ks[8], (L, CONV_WIDTH)),
        "g_fox_out": gain(ks[9], (L, FOX_WIDTH)),
        "w_mix_out": nrm(ks[10], (L, MIX_WIDTH, D_MODEL), MIX_WIDTH ** -0.5),
        "g_xattn": gain(ks[11], (L, D_MODEL)),
        "g_mem": gain(ks[12], (L, D_MODEL)),
        "w_xq": nrm(ks[13], (L, D_MODEL, XATTN_WIDTH), D_MODEL ** -0.5),
        "w_xkv": nrm(ks[14], (L, D_MODEL, 2 * XATTN_WIDTH), D_MODEL ** -0.5),
        "g_xq": gain(ks[15], (L, HEAD_DIM)),
        "g_xk": gain(ks[16], (L, HEAD_DIM)),
        "w_xo": nrm(ks[17], (L, XATTN_WIDTH, D_MODEL), XATTN_WIDTH ** -0.5),
        "g_moe": gain(ks[18], (L, D_MODEL)),
        "w_router": nrm(ks[19], (L, D_MODEL, N_EXPERTS), D_MODEL ** -0.5),
        "b_router": nrm(ks[20], (L, N_EXPERTS), 0.01),
        "w_gate_up": nrm(ks[21], (L, N_EXPERTS, D_MODEL, 2 * D_FF), D_MODEL ** -0.5),
        "b_gate_up": nrm(ks[22], (L, N_EXPERTS, 2 * D_FF), 0.01),
        "w_down": nrm(ks[23], (L, N_EXPERTS, D_FF, D_MODEL), D_FF ** -0.5),
        "b_down": nrm(ks[24], (L, N_EXPERTS, D_MODEL), 0.01),
    }


def reference(x, mem, g_mix, w_mix_in, b_forget, conv_w, g_q, g_k, g_conv_out,
              g_fox_out, w_mix_out, g_xattn, g_mem, w_xq, w_xkv, g_xq, g_xk, w_xo,
              g_moe, w_router, b_router, w_gate_up, b_gate_up, w_down, b_down):
    b, s, d = x.shape
    splits = [CONV_WIDTH, 2 * CONV_WIDTH, 3 * CONV_WIDTH,
              3 * CONV_WIDTH + FOX_WIDTH, 3 * CONV_WIDTH + 2 * FOX_WIDTH,
              3 * CONV_WIDTH + 3 * FOX_WIDTH]
    for l in range(DEPTH):
        h = rms_norm(x, g_mix[l])
        proj = h @ w_mix_in[l]
        u_b, u_c, u_x, q, k, v, f_logit = jnp.split(proj, splits, axis=-1)
        y_conv = u_b * causal_dwconv(u_c * u_x, conv_w[l])
        q = rms_norm(q.reshape(b, s, FOX_HEADS, HEAD_DIM), g_q[l])
        k = rms_norm(k.reshape(b, s, FOX_HEADS, HEAD_DIM), g_k[l])
        v = v.reshape(b, s, FOX_HEADS, HEAD_DIM)
        log_f = jax.nn.log_sigmoid((f_logit + b_forget[l]).astype(jnp.float32))
        y_fox = fox_attention(q, k, v, log_f)
        y_mix = jnp.concatenate([rms_norm(y_conv, g_conv_out[l]),
                                 rms_norm(y_fox, g_fox_out[l])], axis=-1)
        x = x + y_mix @ w_mix_out[l]
        x = x + memory_cross_attention(rms_norm(x, g_xattn[l]), rms_norm(mem, g_mem[l]),
                                       w_xq[l], w_xkv[l], g_xq[l], g_xk[l], w_xo[l])
        h = rms_norm(x, g_moe[l]).reshape(b * s, d)
        x = x + moe(h, w_router[l], b_router[l], w_gate_up[l], b_gate_up[l],
                    w_down[l], b_down[l]).reshape(b, s, d)
    return x
```

```cpp
#include <hip/hip_runtime.h>
#include <cstdio>
#include <cstdint>

constexpr int BATCH = 8, SEQ = 2048, DM = 2048, T = BATCH * SEQ;
constexpr int CONVW = 1024, FOXW = 1024, HD = 128, FH = 8, NPROJ = 6144, MIXIN = 6152;
constexpr int MEMT = 256, XH = 4, XW = 512, NE = 32, TOPK = 4, DFF = 2048;
constexpr int MROWS = BATCH * MEMT;
constexpr float EPS = 1e-6f, SW_LIMIT = 7.0f, SW_ALPHA = 1.702f;
constexpr float ATT_SCALE = 0.08838834764831845f;
constexpr int MAXROWS = T * TOPK + NE * 256;
constexpr int NWAVES = 8, NTHREADS = 512;

constexpr size_t MiB = 1u << 20;
constexpr size_t WS_CTL = 0, CTL_ZERO_BYTES = 65536;
constexpr size_t WS_WMIXIN = 1 * MiB;
constexpr size_t WS_WMIXOUT = WS_WMIXIN + 24 * MiB;
constexpr size_t WS_WXQ = WS_WMIXOUT + 8 * MiB;
constexpr size_t WS_WXKV = WS_WXQ + 2 * MiB;
constexpr size_t WS_WXO = WS_WXKV + 4 * MiB;
constexpr size_t WS_WRG = WS_WXO + 2 * MiB;
constexpr size_t WS_WGU = WS_WRG + 1 * MiB;
constexpr size_t WS_WDN = WS_WGU + 512 * MiB;
constexpr size_t WS_HBF = WS_WDN + 256 * MiB;
constexpr size_t WS_PROJ = WS_HBF + 64 * MiB;
constexpr size_t WS_YMIX = WS_PROJ + 192 * MiB;
constexpr size_t WS_MEMN = WS_YMIX + 64 * MiB;
constexpr size_t WS_KVX = WS_MEMN + 8 * MiB;
constexpr size_t WS_QX = WS_KVX + 4 * MiB;
constexpr size_t WS_OX = WS_QX + 16 * MiB;
constexpr size_t WS_LOGF = WS_OX + 16 * MiB;
constexpr size_t WS_BIAS = WS_LOGF + 1 * MiB;
constexpr size_t WS_TOPI = WS_BIAS + 1 * MiB;
constexpr size_t WS_TOPG = WS_TOPI + 1 * MiB;
constexpr size_t WS_POS = WS_TOPG + 1 * MiB;
constexpr size_t WS_LIST = WS_POS + 1 * MiB;
constexpr size_t WS_GLU = WS_LIST + 1 * MiB;
constexpr size_t WS_Y = WS_GLU + 288 * MiB;
constexpr size_t WS_X2N8 = WS_Y + 288 * MiB;
constexpr size_t WS_SSF = WS_X2N8 + 32 * MiB;
constexpr size_t WS_SS1 = WS_SSF + 1 * MiB;
constexpr size_t WS_SS2 = WS_SS1 + 2 * MiB;
constexpr size_t WS_RSTD2 = WS_SS2 + 2 * MiB;
constexpr size_t WS_RSS = WS_RSTD2 + 1 * MiB;
constexpr size_t WS_END = WS_RSS + 1 * MiB;

constexpr int CW_COUNTS = 8192;
constexpr int CW_CURSOR = 12288;
constexpr int CW_BAR = 4096;

constexpr int LDS_BYTES = 163840;
constexpr int RSS_OFF = 134144, RSS_UNITS = 24;
constexpr int TABLE_OFF = 131072;
constexpr int MISC_OFF = 163328;
#ifndef ONE_LAUNCH
#define ONE_LAUNCH 1
#endif

#define GAS __attribute__((address_space(1)))
#define LAS __attribute__((address_space(3)))
typedef unsigned short bf16;
typedef unsigned v4u __attribute__((ext_vector_type(4)));
typedef unsigned v2u __attribute__((ext_vector_type(2)));
typedef float f32x4 __attribute__((ext_vector_type(4)));
typedef float f32x16 __attribute__((ext_vector_type(16)));
typedef short bf16x8 __attribute__((ext_vector_type(8)));
typedef int v8i __attribute__((ext_vector_type(8)));
typedef short s16x16 __attribute__((ext_vector_type(16)));

__device__ __forceinline__ float bf2f(unsigned u16) { return __builtin_bit_cast(float, u16 << 16); }
__device__ __forceinline__ unsigned f2bf(float f) { unsigned u = __builtin_bit_cast(unsigned, f); return (u + 0x7fffu + ((u >> 16) & 1u)) >> 16; }
__device__ __forceinline__ unsigned pk2(float lo, float hi) { return f2bf(lo) | (f2bf(hi) << 16); }
__device__ __forceinline__ float lo16(unsigned w) { return __builtin_bit_cast(float, w << 16); }
__device__ __forceinline__ float hi16(unsigned w) { return __builtin_bit_cast(float, w & 0xffff0000u); }
__device__ __forceinline__ float wave_sum(float v) {
#pragma unroll
    for (int o = 1; o < 64; o <<= 1) v += __shfl_xor(v, o);
    return v;
}
__device__ __forceinline__ void unpack8(v4u w, float* f) {
    f[0] = lo16(w.x); f[1] = hi16(w.x); f[2] = lo16(w.y); f[3] = hi16(w.y); f[4] = lo16(w.z); f[5] = hi16(w.z); f[6] = lo16(w.w); f[7] = hi16(w.w);
}
__device__ __forceinline__ v4u pack8(const float* f) { v4u w; w.x = pk2(f[0], f[1]); w.y = pk2(f[2], f[3]); w.z = pk2(f[4], f[5]); w.w = pk2(f[6], f[7]); return w; }


#define XB_TMO      128
#define XB_XCNT(j)  (256  + 64 * (j))
#define XB_XSUB(j)  (1280 + 64 * (j))
#define XB_XGEN(j)  (2304 + 64 * (j))
#define XB_TOP      3328
#define XB_TOPGEN   3392
#define XCD_BAR_WORDS 3456
#define XB_SPIN_CAP (1u << 18)
__device__ __forceinline__ unsigned xb_ld(unsigned* p)              { return __hip_atomic_load(p, __ATOMIC_RELAXED, __HIP_MEMORY_SCOPE_AGENT); }
__device__ __forceinline__ unsigned xb_add(unsigned* p, unsigned v) { return __hip_atomic_fetch_add(p, v, __ATOMIC_RELAXED, __HIP_MEMORY_SCOPE_AGENT); }
__device__ __forceinline__ unsigned xb_xcc_id() { return (unsigned)__builtin_amdgcn_s_getreg((3 << 11) | 20) & 0xFu; }
#define XB_SPIN(cond, bar) do { unsigned _sp = 0; while (cond) { __builtin_amdgcn_s_sleep(1); \
    if ((++_sp & 255u) == 0u) { if (xb_ld(&(bar)[XB_TMO])) break; if (_sp > XB_SPIN_CAP) { atomicAdd(&(bar)[XB_TMO], 1u); break; } } } } while (0)
struct XcdBarrier { unsigned* bar; unsigned x; volatile LAS unsigned* st; };
__device__ __forceinline__ XcdBarrier xcd_barrier_post(unsigned* bar, volatile LAS unsigned* st) {
    XcdBarrier b; b.bar = bar; b.x = xb_xcc_id(); b.st = st;
    if (threadIdx.x == 0) (void)xb_add(&bar[XB_XCNT(b.x)], 1u);
    return b;
}
__device__ __forceinline__ void xcd_barrier_complete(unsigned* bar, unsigned x, unsigned& nloc, unsigned& nx) {
    const unsigned G = gridDim.x * gridDim.y * gridDim.z;
    unsigned sum, cnt, mine, sp = 0u;
    for (;;) {
        sum = 0u; cnt = 0u; mine = 0u;
#pragma unroll
        for (unsigned j = 0; j < 16; ++j) { const unsigned c = xb_ld(&bar[XB_XCNT(j)]); sum += c; cnt += (c > 0u) ? 1u : 0u; mine = (j == x) ? c : mine; }
        if (sum == G) break;
        __builtin_amdgcn_s_sleep(1);
        if ((++sp & 255u) == 0u) { if (xb_ld(&bar[XB_TMO])) break; if (sp > XB_SPIN_CAP) { atomicAdd(&bar[XB_TMO], 1u); break; } }
    }
    nloc = mine > 0u ? mine : 1u; nx = cnt > 0u ? cnt : 1u;
}
__device__ __noinline__ void xcd_barrier_nb(unsigned* bar_, unsigned x_, volatile LAS unsigned* st_) {
    XcdBarrier b; b.bar = bar_; b.x = x_; b.st = st_;
    asm volatile("s_waitcnt vmcnt(0)" ::: "memory");
    __syncthreads();
    if (threadIdx.x == 0) {
        unsigned* bar = b.bar;
        __builtin_amdgcn_s_waitcnt(0);
        unsigned nloc = b.st[0], nx = b.st[1];
        if (nloc == 0u) { xcd_barrier_complete(bar, b.x, nloc, nx); b.st[0] = nloc; b.st[1] = nx; }
        const unsigned old = xb_add(&bar[XB_XSUB(b.x)], 1u);
        const unsigned gen = old / nloc;
        if (old + 1u == (gen + 1u) * nloc) {
            __builtin_amdgcn_fence(__ATOMIC_RELEASE, "agent");
            asm volatile("s_waitcnt vmcnt(0)" ::: "memory");
            const unsigned og = xb_add(&bar[XB_TOP], 1u);
            const unsigned tg = og / nx;
            if (og + 1u == (tg + 1u) * nx) xb_add(&bar[XB_TOPGEN], 1u);
            else XB_SPIN(xb_ld(&bar[XB_TOPGEN]) == tg, bar);
            __builtin_amdgcn_fence(__ATOMIC_ACQUIRE, "agent");
            xb_add(&bar[XB_XGEN(b.x)], 1u);
            asm volatile("s_waitcnt vmcnt(0)" ::: "memory");
        } else {
            XB_SPIN(xb_ld(&bar[XB_XGEN(b.x)]) == gen, bar);
            __builtin_amdgcn_fence(__ATOMIC_ACQUIRE, "agent");
            asm volatile("s_waitcnt vmcnt(0)" ::: "memory");
        }
    }
    __syncthreads();
}

struct Args { const float* in[25]; float* out; unsigned char* ws; int ph_lo, ph_hi; };
enum { I_X = 0, I_MEM, I_GMIX, I_WMIXIN, I_BFORGET, I_CONVW, I_GQ, I_GK, I_GCONV, I_GFOX, I_WMIXOUT, I_GXATTN, I_GMEM, I_WXQ, I_WXKV, I_GXQ, I_GXK, I_WXO,
       I_GMOE, I_WROUTER, I_BROUTER, I_WGU, I_BGU, I_WDN, I_BDN };

struct Frame {
    LAS unsigned char* lds;
    unsigned* ctl;
    int tid, lane, wave, vcu, G, gw, NGW;
    const float* const* in; float* out; unsigned char* ws;
};

__device__ __forceinline__ void transpose_item(const float* W, int ldw, int K, int k0, int n0, bf16* WT, int drow0, LAS float* scr, int lane, int kd0, const float* gk) {
    float r_[32];
#pragma unroll
    for (int i = 0; i < 32; ++i) { const int kk = 2 * i + (lane >> 5); r_[i] = W[(size_t)(k0 + kk) * ldw + n0 + (lane & 31)]; }
    if (gk) {
#pragma unroll
        for (int i = 0; i < 32; ++i) r_[i] *= gk[2 * i + (lane >> 5)]; }
#pragma unroll
    for (int i = 0; i < 32; ++i) { const int kk = 2 * i + (lane >> 5); scr[kk * 33 + (lane & 31)] = r_[i]; }
    asm volatile("s_waitcnt lgkmcnt(0)" ::: "memory");
    const int c = lane & 7;
#pragma unroll
    for (int j = 0; j < 4; ++j) { const int n = (lane >> 3) + 8 * j; const LAS float* s = scr + (8 * c) * 33 + n;
        v4u o; o.x = pk2(s[0 * 33], s[1 * 33]); o.y = pk2(s[2 * 33], s[3 * 33]); o.z = pk2(s[4 * 33], s[5 * 33]); o.w = pk2(s[6 * 33], s[7 * 33]);
        *(v4u*)(WT + (size_t)(drow0 + n) * K + kd0 + 8 * c) = o; }
    asm volatile("s_waitcnt lgkmcnt(0)" ::: "memory");
}


__device__ __forceinline__ void rms_row_2048(const float* xrow, const float* gain, bf16* orow, int lane, f32x4 (&v)[8]) {
    const f32x4* xr = (const f32x4*)xrow + lane; const f32x4* gr = (const f32x4*)gain + lane;
    float s = 0.f; f32x4 gv[8];
#pragma unroll
    for (int j = 0; j < 8; ++j) { v[j] = xr[64 * j]; gv[j] = gr[64 * j]; }
#pragma unroll
    for (int j = 0; j < 8; ++j) s += (v[j].x * v[j].x + v[j].y * v[j].y) + (v[j].z * v[j].z + v[j].w * v[j].w);
    const float rstd = 1.f / sqrtf(wave_sum(s) * (1.f / 2048.f) + EPS);
    v2u* o8 = (v2u*)orow + lane;
#pragma unroll
    for (int j = 0; j < 8; ++j) { const f32x4 g = gv[j]; v[j] = v[j] * rstd * g; v2u w; w.x = pk2(v[j].x, v[j].y); w.y = pk2(v[j].z, v[j].w); o8[64 * j] = w; }
}

__device__ __forceinline__ float log_sigmoid(float z) { return fminf(z, 0.f) - log1pf(expf(-fabsf(z))); }

namespace pg8 {
constexpr int BM = 256, BK = 64, HALF = 128, HTB = HALF * BK * 2, NXCD = 8, WGM = 8;
__host__ __device__ __forceinline__ int lds_byte(int r, int c) { const int st = (r >> 4) * 2 + (c >> 5), rr = r & 15, cc = c & 31, ob = rr * 64 + cc * 2; return st * 1024 + (ob ^ (((ob >> 9) & 1) << 5)); }
__host__ __device__ __forceinline__ void stage_rc(int b, int& R, int& C) { const int st = b / 1024, sb = b % 1024, swz = sb ^ (((sb >> 9) & 1) << 5); R = (st >> 1) * 16 + swz / 64; C = (st & 1) * 32 + (swz % 64) / 2; }
__host__ __device__ __forceinline__ int perm32(int rho) { const int n = rho >> 4, i = rho & 15; return 8 * (i >> 2) + 4 * n + (i & 3); }
struct Unit { int pm, pn; const char* A; const char* B; };
__device__ __forceinline__ unsigned cvt_pk_bf16(float lo, float hi) { unsigned r; asm volatile("v_cvt_pk_bf16_f32 %0, %1, %2" : "=v"(r) : "v"(lo), "v"(hi)); return r; }
__device__ __forceinline__ unsigned pk4_fp8(float a, float b, float c, float d) { int w = 0; w = __builtin_amdgcn_cvt_pk_fp8_f32(a, b, w, false); w = __builtin_amdgcn_cvt_pk_fp8_f32(c, d, w, true); return (unsigned)w; }

struct DenseOrder {
    int nM, nN, nwg, G, c; const char* A; const char* B; size_t tstep;
    __device__ void init(const void* A_, const void* B_, int M, int N, int K, int G_, int c_) { nM = M / BM; nN = N / BM; nwg = nM * nN; G = G_; c = c_; A = (const char*)A_; B = (const char*)B_; tstep = (size_t)BM * K * 2; }
    __device__ bool next(int i, Unit& u) const {
        const long L = (long)i * G + c; if (L >= nwg) return false;
        int wgid = (int)L; { const int q = nwg / NXCD, r = nwg % NXCD, xcd = wgid % NXCD, off = wgid / NXCD; wgid = (xcd < r ? xcd * (q + 1) : r * (q + 1) + (xcd - r) * q) + off; }
        const int nig = WGM * nN, gid = wgid / nig, fm = gid * WGM, gsz = (nM - fm) < WGM ? (nM - fm) : WGM;
        u.pm = fm + ((wgid % nig) % gsz); u.pn = (wgid % nig) / gsz; u.A = A + (size_t)u.pm * tstep; u.B = B + (size_t)u.pn * tstep; return true;
    }
    __device__ __forceinline__ int row(int) const { return 0; }
};

template <class Epi, class Sched, bool GATHER, bool ALIGN_EPI, bool MID = false>
__device__ __forceinline__ void gemm_phase(LAS unsigned char* lds, const int K, const Sched& S, const Epi& E) {
    const int tid = threadIdx.x, wid = __builtin_amdgcn_readfirstlane(tid >> 6), lane = tid & 63, wr = wid >> 2, wc = wid & 3, fr = lane & 15, fq = lane >> 4;
    const int nt = K / BK;
    unsigned voffB[2]; int RA[2], CA[2];
#pragma unroll
    for (int i = 0; i < 2; ++i) { int R, C; stage_rc(tid * 16 + i * 8192, R, C); const int Rb = (R & ~31) + perm32(R & 31); RA[i] = R; CA[i] = C; voffB[i] = (unsigned)(Rb * K + C) * 2u; }
    const size_t kstep = (size_t)(BK * 2);
    const size_t hstep = (size_t)HALF * K * 2;
    const unsigned ldsw = (unsigned)wid * 1024u;
    const int aoff = lds_byte(wr * 64 + fr, fq * 8), boff = lds_byte(wc * 32 + fr, fq * 8);
#define PG8_SA(b, h) (((b) * 2 + (h)) * HTB)
#define PG8_SB(b, h) ((4 + (b) * 2 + (h)) * HTB)
#define PG8_STAGEB(bufoff, gbase) do { _Pragma("unroll") for (int _i = 0; _i < 2; ++_i) \
        __builtin_amdgcn_global_load_lds((const unsigned*)((const char*)(gbase) + voffB[_i]), (LAS unsigned*)(lds + (bufoff) + ldsw + _i * 8192), 16, 0, 0); } while (0)
#define PG8_STAGEA(bufoff, gbase, vo, h) do { _Pragma("unroll") for (int _i = 0; _i < 2; ++_i) \
        __builtin_amdgcn_global_load_lds((const unsigned*)((const char*)(gbase) + (vo)[h][_i]), (LAS unsigned*)(lds + (bufoff) + ldsw + _i * 8192), 16, 0, 0); } while (0)
#define PG8_LDA(dst, b, h) do { _Pragma("unroll") for (int m = 0; m < 4; ++m) _Pragma("unroll") for (int k = 0; k < 2; ++k) dst[m][k] = *(const LAS bf16x8*)(lds + PG8_SA(b, h) + aoff + m * 2048 + k * 1024); } while (0)
#define PG8_LDB(dst, b, h) do { _Pragma("unroll") for (int n = 0; n < 2; ++n) _Pragma("unroll") for (int k = 0; k < 2; ++k) dst[n][k] = *(const LAS bf16x8*)(lds + PG8_SB(b, h) + boff + n * 2048 + k * 1024); } while (0)
#define PG8_MMA(ai, bj, At, Bt) do { __builtin_amdgcn_s_setprio(1); _Pragma("unroll") for (int m = 0; m < 4; ++m) _Pragma("unroll") for (int n = 0; n < 2; ++n) _Pragma("unroll") for (int k = 0; k < 2; ++k) \
        acc[ai][bj][m][n] = __builtin_amdgcn_mfma_f32_16x16x32_bf16(Bt[n][k], At[m][k], acc[ai][bj][m][n], 0, 0, 0); __builtin_amdgcn_s_setprio(0); } while (0)
#define PG8_WAIT_V(n) asm volatile("s_waitcnt vmcnt(" #n ")" ::: "memory")
#define PG8_WAIT_L(n) asm volatile("s_waitcnt lgkmcnt(" #n ")" ::: "memory")
#define PG8_BAR __builtin_amdgcn_s_barrier()
#define PG8_SCHED __builtin_amdgcn_sched_barrier(0)
#define PG8_SETA(vo, u) do { _Pragma("unroll") for (int _h = 0; _h < 2; ++_h) _Pragma("unroll") for (int _i = 0; _i < 2; ++_i) { \
        if constexpr (GATHER) (vo)[_h][_i] = (unsigned)S.row((u).pm * BM + _h * HALF + RA[_i]) * (unsigned)(K * 2) + (unsigned)(CA[_i] * 2); \
        else (vo)[_h][_i] = (unsigned)((_h * HALF + RA[_i]) * K + CA[_i]) * 2u; } } while (0)
    Unit cur, nxt; int ui = 0;
    if (!S.next(0, cur)) return;
    f32x4 acc[2][2][4][2];
#pragma unroll
    for (int a = 0; a < 2; ++a)
#pragma unroll
        for (int b = 0; b < 2; ++b)
#pragma unroll
            for (int m = 0; m < 4; ++m)
#pragma unroll
                for (int n = 0; n < 2; ++n) acc[a][b][m][n] = (f32x4){0.f, 0.f, 0.f, 0.f};
    bf16x8 At[4][2], B0[2][2], B1[2][2];
    unsigned vC[2][2], vN[2][2];
    PG8_SETA(vC, cur);
    const char* cA = cur.A; const char* cB = cur.B;
    PG8_STAGEB(PG8_SB(0, 0), cB); PG8_STAGEB(PG8_SB(0, 1), cB + hstep); PG8_STAGEA(PG8_SA(0, 0), cA, vC, 0); PG8_STAGEA(PG8_SA(0, 1), cA, vC, 1);
    if (wr == 1) PG8_BAR;
    PG8_WAIT_V(2); PG8_BAR;
    PG8_STAGEB(PG8_SB(1, 0), cB + kstep); PG8_STAGEA(PG8_SA(1, 0), cA + kstep, vC, 0); PG8_STAGEB(PG8_SB(1, 1), cB + hstep + kstep);
    PG8_WAIT_V(6); PG8_BAR;
    for (;;) {
        const bool has_next = S.next(ui + 1, nxt);
        const char* nA = has_next ? nxt.A : cA; const char* nB = has_next ? nxt.B : cB;
        if constexpr (GATHER) { if (has_next) PG8_SETA(vN, nxt); else {
#pragma unroll
            for (int _h = 0; _h < 2; ++_h)
#pragma unroll
                for (int _i = 0; _i < 2; ++_i) vN[_h][_i] = vC[_h][_i]; } }
        for (int t = 0; t < nt; t += 2) {
            if constexpr (MID) { if (t == nt / 2) E.mid(acc, cur, wr, fr, ui); }
            const bool last = (t == nt - 2);
            const char* a1 = cA + (size_t)(t + 1) * kstep;
            const char* a2 = last ? nA : cA + (size_t)(t + 2) * kstep; const char* b2 = last ? nB : cB + (size_t)(t + 2) * kstep;
            const char* a3 = a2 + kstep; const char* b3 = b2 + kstep;
            unsigned v2[2][2];
#pragma unroll
            for (int _h = 0; _h < 2; ++_h)
#pragma unroll
                for (int _i = 0; _i < 2; ++_i) { if constexpr (GATHER) v2[_h][_i] = last ? vN[_h][_i] : vC[_h][_i]; else v2[_h][_i] = vC[_h][_i]; }
            PG8_LDB(B0, 0, 0); PG8_LDB(B1, 0, 1); PG8_SCHED; PG8_LDA(At, 0, 0); PG8_STAGEA(PG8_SA(1, 1), a1, vC, 1);
            PG8_WAIT_V(8); PG8_WAIT_L(0); PG8_BAR; PG8_MMA(0, 0, At, B0); PG8_MMA(0, 1, At, B1); PG8_BAR; PG8_SCHED;
            PG8_LDA(At, 0, 1); PG8_STAGEB(PG8_SB(0, 0), b2); PG8_STAGEB(PG8_SB(0, 1), b2 + hstep); PG8_STAGEA(PG8_SA(0, 0), a2, v2, 0);
            PG8_WAIT_V(8); PG8_WAIT_L(0); PG8_BAR; PG8_MMA(1, 0, At, B0); PG8_MMA(1, 1, At, B1); PG8_BAR; PG8_SCHED;
            PG8_LDB(B0, 1, 0); PG8_LDB(B1, 1, 1); PG8_SCHED; PG8_LDA(At, 1, 0); PG8_STAGEA(PG8_SA(0, 1), a2, v2, 1);
            PG8_WAIT_V(8); PG8_WAIT_L(0); PG8_BAR; PG8_MMA(0, 0, At, B0); PG8_MMA(0, 1, At, B1); PG8_BAR; PG8_SCHED;
            PG8_LDA(At, 1, 1); PG8_STAGEB(PG8_SB(1, 0), b3); PG8_STAGEB(PG8_SB(1, 1), b3 + hstep); PG8_STAGEA(PG8_SA(1, 0), a3, v2, 0);
            PG8_WAIT_V(8); PG8_WAIT_L(0); PG8_BAR; PG8_MMA(1, 0, At, B0); PG8_MMA(1, 1, At, B1); PG8_BAR; PG8_SCHED;
        }
        if constexpr (ALIGN_EPI) { if (wr == 0) PG8_BAR; }
        E(acc, cur, wr, wc, fr, fq);
        if (!has_next) break;
#pragma unroll
        for (int a = 0; a < 2; ++a)
#pragma unroll
            for (int b = 0; b < 2; ++b)
#pragma unroll
                for (int m = 0; m < 4; ++m)
#pragma unroll
                    for (int n = 0; n < 2; ++n) acc[a][b][m][n] = (f32x4){0.f, 0.f, 0.f, 0.f};
        cur = nxt; cA = nA; cB = nB; ++ui;
        if constexpr (GATHER) {
#pragma unroll
            for (int _h = 0; _h < 2; ++_h)
#pragma unroll
                for (int _i = 0; _i < 2; ++_i) vC[_h][_i] = vN[_h][_i]; }
        if constexpr (ALIGN_EPI) { if (wr == 1) PG8_BAR; }
    }
    PG8_WAIT_V(0);
    if constexpr (!ALIGN_EPI) { if (wr == 0) PG8_BAR; }
    PG8_BAR;
#undef PG8_SA
#undef PG8_SB
#undef PG8_STAGEA
#undef PG8_STAGEB
#undef PG8_LDA
#undef PG8_LDB
#undef PG8_MMA
#undef PG8_WAIT_V
#undef PG8_WAIT_L
#undef PG8_BAR
#undef PG8_SCHED
#undef PG8_SETA
}

template <class Epi, class Sched, bool GATHER, bool ALIGN_EPI>
__device__ __forceinline__ void gemm_phase8(LAS unsigned char* lds, const int KB, const Sched& S, const Epi& E) {
    const int tid = threadIdx.x, wid = __builtin_amdgcn_readfirstlane(tid >> 6), lane = tid & 63, wr = wid >> 2, wc = wid & 3, fr = lane & 15, fq = lane >> 4;
    const int nt = KB / 128;
    unsigned voffB[2]; int RA[2], CA[2];
#pragma unroll
    for (int i = 0; i < 2; ++i) { int R, C; stage_rc(tid * 16 + i * 8192, R, C); const int Rb = (R & ~31) + perm32(R & 31); RA[i] = R; CA[i] = C; voffB[i] = (unsigned)(Rb * KB + C * 2); }
    const size_t kstep = (size_t)(BK * 2);
    const size_t hstep = (size_t)HALF * KB;
    const unsigned ldsw = (unsigned)wid * 1024u;
    const int aoff = lds_byte(wr * 64 + fr, fq * 8), boff = lds_byte(wc * 32 + fr, fq * 8);
#define PG8_SA(b, h) (((b) * 2 + (h)) * HTB)
#define PG8_SB(b, h) ((4 + (b) * 2 + (h)) * HTB)
#define PG8_STAGEB(bufoff, gbase) do { _Pragma("unroll") for (int _i = 0; _i < 2; ++_i) \
        __builtin_amdgcn_global_load_lds((const unsigned*)((const char*)(gbase) + voffB[_i]), (LAS unsigned*)(lds + (bufoff) + ldsw + _i * 8192), 16, 0, 0); } while (0)
#define PG8_STAGEA(bufoff, gbase, vo, h) do { _Pragma("unroll") for (int _i = 0; _i < 2; ++_i) \
        __builtin_amdgcn_global_load_lds((const unsigned*)((const char*)(gbase) + (vo)[h][_i]), (LAS unsigned*)(lds + (bufoff) + ldsw + _i * 8192), 16, 0, 0); } while (0)
#define PG8_LDA(dst, b, h) do { _Pragma("unroll") for (int m = 0; m < 4; ++m) { const bf16x8 lo_ = *(const LAS bf16x8*)(lds + PG8_SA(b, h) + aoff + m * 2048), hi_ = *(const LAS bf16x8*)(lds + PG8_SA(b, h) + aoff + m * 2048 + 1024); dst[m] = __builtin_bit_cast(v8i, __builtin_shufflevector(lo_, hi_, 0, 1, 2, 3, 4, 5, 6, 7, 8, 9, 10, 11, 12, 13, 14, 15)); } } while (0)
#define PG8_LDB(dst, b, h) do { _Pragma("unroll") for (int n = 0; n < 2; ++n) { const bf16x8 lo_ = *(const LAS bf16x8*)(lds + PG8_SB(b, h) + boff + n * 2048), hi_ = *(const LAS bf16x8*)(lds + PG8_SB(b, h) + boff + n * 2048 + 1024); dst[n] = __builtin_bit_cast(v8i, __builtin_shufflevector(lo_, hi_, 0, 1, 2, 3, 4, 5, 6, 7, 8, 9, 10, 11, 12, 13, 14, 15)); } } while (0)
#define PG8_MMA(ai, bj, At, Bt) do { __builtin_amdgcn_s_setprio(1); _Pragma("unroll") for (int m = 0; m < 4; ++m) _Pragma("unroll") for (int n = 0; n < 2; ++n) \
        asm volatile("v_mfma_f32_16x16x128_f8f6f4 %0, %1, %2, %0" : "+v"(acc[ai][bj][m][n]) : "v"(Bt[n]), "v"(At[m])); __builtin_amdgcn_s_setprio(0); } while (0)
#define PG8_WAIT_V(n) asm volatile("s_waitcnt vmcnt(" #n ")" ::: "memory")
#define PG8_WAIT_L(n) asm volatile("s_waitcnt lgkmcnt(" #n ")" ::: "memory")
#define PG8_BAR __builtin_amdgcn_s_barrier()
#define PG8_SCHED __builtin_amdgcn_sched_barrier(0)
#define PG8_SETA(vo, u) do { _Pragma("unroll") for (int _h = 0; _h < 2; ++_h) _Pragma("unroll") for (int _i = 0; _i < 2; ++_i) { \
        if constexpr (GATHER) (vo)[_h][_i] = (unsigned)S.row((u).pm * BM + _h * HALF + RA[_i]) * (unsigned)KB + (unsigned)(CA[_i] * 2); \
        else (vo)[_h][_i] = (unsigned)((_h * HALF + RA[_i]) * KB + CA[_i] * 2); } } while (0)
    Unit cur, nxt; int ui = 0;
    if (!S.next(0, cur)) return;
    f32x4 acc[2][2][4][2];
#pragma unroll
    for (int a = 0; a < 2; ++a)
#pragma unroll
        for (int b = 0; b < 2; ++b)
#pragma unroll
            for (int m = 0; m < 4; ++m)
#pragma unroll
                for (int n = 0; n < 2; ++n) acc[a][b][m][n] = (f32x4){0.f, 0.f, 0.f, 0.f};
    v8i At[4], B0[2], B1[2];
    unsigned vC[2][2], vN[2][2];
    PG8_SETA(vC, cur);
    const char* cA = cur.A; const char* cB = cur.B;
    PG8_STAGEB(PG8_SB(0, 0), cB); PG8_STAGEB(PG8_SB(0, 1), cB + hstep); PG8_STAGEA(PG8_SA(0, 0), cA, vC, 0); PG8_STAGEA(PG8_SA(0, 1), cA, vC, 1);
    if (wr == 1) PG8_BAR;
    PG8_WAIT_V(2); PG8_BAR;
    PG8_STAGEB(PG8_SB(1, 0), cB + kstep); PG8_STAGEA(PG8_SA(1, 0), cA + kstep, vC, 0); PG8_STAGEB(PG8_SB(1, 1), cB + hstep + kstep);
    PG8_WAIT_V(6); PG8_BAR;
    for (;;) {
        const bool has_next = S.next(ui + 1, nxt);
        const char* nA = has_next ? nxt.A : cA; const char* nB = has_next ? nxt.B : cB;
        if constexpr (GATHER) { if (has_next) PG8_SETA(vN, nxt); else {
#pragma unroll
            for (int _h = 0; _h < 2; ++_h)
#pragma unroll
                for (int _i = 0; _i < 2; ++_i) vN[_h][_i] = vC[_h][_i]; } }
        for (int t = 0; t < nt; t += 2) {
            const bool last = (t == nt - 2);
            const char* a1 = cA + (size_t)(t + 1) * kstep;
            const char* a2 = last ? nA : cA + (size_t)(t + 2) * kstep; const char* b2 = last ? nB : cB + (size_t)(t + 2) * kstep;
            const char* a3 = a2 + kstep; const char* b3 = b2 + kstep;
            unsigned v2[2][2];
#pragma unroll
            for (int _h = 0; _h < 2; ++_h)
#pragma unroll
                for (int _i = 0; _i < 2; ++_i) { if constexpr (GATHER) v2[_h][_i] = last ? vN[_h][_i] : vC[_h][_i]; else v2[_h][_i] = vC[_h][_i]; }
            PG8_LDB(B0, 0, 0); PG8_LDB(B1, 0, 1); PG8_SCHED; PG8_LDA(At, 0, 0); PG8_STAGEA(PG8_SA(1, 1), a1, vC, 1);
            PG8_WAIT_V(8); PG8_WAIT_L(0); PG8_BAR; PG8_MMA(0, 0, At, B0); PG8_MMA(0, 1, At, B1); PG8_BAR; PG8_SCHED;
            PG8_LDA(At, 0, 1); PG8_STAGEB(PG8_SB(0, 0), b2); PG8_STAGEB(PG8_SB(0, 1), b2 + hstep); PG8_STAGEA(PG8_SA(0, 0), a2, v2, 0);
            PG8_WAIT_V(8); PG8_WAIT_L(0); PG8_BAR; PG8_MMA(1, 0, At, B0); PG8_MMA(1, 1, At, B1); PG8_BAR; PG8_SCHED;
            PG8_LDB(B0, 1, 0); PG8_LDB(B1, 1, 1); PG8_SCHED; PG8_LDA(At, 1, 0); PG8_STAGEA(PG8_SA(0, 1), a2, v2, 1);
            PG8_WAIT_V(8); PG8_WAIT_L(0); PG8_BAR; PG8_MMA(0, 0, At, B0); PG8_MMA(0, 1, At, B1); PG8_BAR; PG8_SCHED;
            PG8_LDA(At, 1, 1); PG8_STAGEB(PG8_SB(1, 0), b3); PG8_STAGEB(PG8_SB(1, 1), b3 + hstep); PG8_STAGEA(PG8_SA(1, 0), a3, v2, 0);
            PG8_WAIT_V(8); PG8_WAIT_L(0); PG8_BAR; PG8_MMA(1, 0, At, B0); PG8_MMA(1, 1, At, B1); PG8_BAR; PG8_SCHED;
        }
        if constexpr (ALIGN_EPI) { if (wr == 0) PG8_BAR; }
        asm volatile("s_nop 15\n\ts_nop 15" ::: "memory");
        E(acc, cur, wr, wc, fr, fq, ui);
        if (!has_next) break;
#pragma unroll
        for (int a = 0; a < 2; ++a)
#pragma unroll
            for (int b = 0; b < 2; ++b)
#pragma unroll
                for (int m = 0; m < 4; ++m)
#pragma unroll
                    for (int n = 0; n < 2; ++n) acc[a][b][m][n] = (f32x4){0.f, 0.f, 0.f, 0.f};
        cur = nxt; cA = nA; cB = nB; ++ui;
        if constexpr (GATHER) {
#pragma unroll
            for (int _h = 0; _h < 2; ++_h)
#pragma unroll
                for (int _i = 0; _i < 2; ++_i) vC[_h][_i] = vN[_h][_i]; }
        if constexpr (ALIGN_EPI) { if (wr == 1) PG8_BAR; }
    }
    PG8_WAIT_V(0);
    if constexpr (!ALIGN_EPI) { if (wr == 0) PG8_BAR; }
    PG8_BAR;
#undef PG8_SA
#undef PG8_SB
#undef PG8_STAGEA
#undef PG8_STAGEB
#undef PG8_LDA
#undef PG8_LDB
#undef PG8_MMA
#undef PG8_WAIT_V
#undef PG8_WAIT_L
#undef PG8_BAR
#undef PG8_SCHED
#undef PG8_SETA
}


__device__ __forceinline__ void head_norm(f32x4 (&acc)[2][2][4][2], LAS float* part, const float* gain, const LAS float* epsrow, int wr, int wc, int fr, int fq) {
#pragma unroll
    for (int ai = 0; ai < 2; ++ai)
#pragma unroll
        for (int m = 0; m < 4; ++m) { const int rl = ai * HALF + wr * 64 + m * 16 + fr;
#pragma unroll
            for (int bj = 0; bj < 2; ++bj) { const f32x4 a = acc[ai][bj][m][0], b = acc[ai][bj][m][1];
                float sq = (a[0] * a[0] + a[1] * a[1]) + (a[2] * a[2] + a[3] * a[3]) + (b[0] * b[0] + b[1] * b[1]) + (b[2] * b[2] + b[3] * b[3]);
                sq += __shfl_xor(sq, 16); sq += __shfl_xor(sq, 32);
                if (fq == 0) part[(rl * 2 + bj) * 4 + wc] = sq; } }
    asm volatile("s_waitcnt lgkmcnt(0)" ::: "memory"); __builtin_amdgcn_s_barrier(); asm volatile("" ::: "memory");
    const f32x4 g0 = *(const f32x4*)(gain + wc * 32 + 8 * fq), g1 = *(const f32x4*)(gain + wc * 32 + 8 * fq + 4);
#pragma unroll
    for (int ai = 0; ai < 2; ++ai)
#pragma unroll
        for (int m = 0; m < 4; ++m) { const int rl = ai * HALF + wr * 64 + m * 16 + fr; const float eps = epsrow ? epsrow[rl] : EPS;
#pragma unroll
            for (int bj = 0; bj < 2; ++bj) { const f32x4 p = *(const LAS f32x4*)(part + (rl * 2 + bj) * 4);
                const float rs = 1.f / sqrtf(((p[0] + p[1]) + (p[2] + p[3])) * (1.f / 128.f) + eps);
                acc[ai][bj][m][0] = acc[ai][bj][m][0] * rs * g0; acc[ai][bj][m][1] = acc[ai][bj][m][1] * rs * g1; } }
}
__device__ __forceinline__ void store_tile_bf16(const f32x4 (&acc)[2][2][4][2], bf16* O, int ldc, int row0, int col0) {
#pragma unroll
    for (int ai = 0; ai < 2; ++ai)
#pragma unroll
        for (int m = 0; m < 4; ++m) { bf16* rowp = O + (size_t)(row0 + ai * HALF + m * 16) * ldc + col0;
#pragma unroll
            for (int bj = 0; bj < 2; ++bj) { const f32x4 v0 = acc[ai][bj][m][0], v1 = acc[ai][bj][m][1]; v4u w; w.x = cvt_pk_bf16(v0[0], v0[1]); w.y = cvt_pk_bf16(v0[2], v0[3]); w.z = cvt_pk_bf16(v1[0], v1[1]); w.w = cvt_pk_bf16(v1[2], v1[3]);
                *(v4u*)(rowp + bj * HALF) = w; } }
}
struct EpiProj { bf16* O; const float* gq; const float* gk; LAS float* part;
    __device__ __forceinline__ void operator()(f32x4 (&acc)[2][2][4][2], const Unit& u, int wr, int wc, int fr, int fq) const {
        const bool prod = u.pn >= 4 && u.pn < 12;
        if (prod) {
#pragma unroll
            for (int ai = 0; ai < 2; ++ai)
#pragma unroll
                for (int m = 0; m < 4; ++m) { acc[ai][0][m][0] *= acc[ai][1][m][0]; acc[ai][0][m][1] *= acc[ai][1][m][1]; } }
        if (u.pn >= 12 && u.pn < 20) head_norm(acc, part, u.pn < 16 ? gq : gk, nullptr, wr, wc, fr, fq);
        const int row0 = u.pm * BM + wr * 64 + fr, col0 = (prod ? 1024 + (u.pn - 4) * HALF : u.pn * BM) + wc * 32 + 8 * fq;
#pragma unroll
        for (int ai = 0; ai < 2; ++ai)
#pragma unroll
            for (int m = 0; m < 4; ++m) { bf16* rowp = O + (size_t)(row0 + ai * HALF + m * 16) * NPROJ + col0;
#pragma unroll
                for (int bj = 0; bj < 2; ++bj) { const f32x4 v0 = acc[ai][bj][m][0], v1 = acc[ai][bj][m][1]; v4u w; w.x = cvt_pk_bf16(v0[0], v0[1]); w.y = cvt_pk_bf16(v0[2], v0[3]); w.z = cvt_pk_bf16(v1[0], v1[1]); w.w = cvt_pk_bf16(v1[2], v1[3]);
                    if (bj == 0 || !prod) *(v4u*)(rowp + bj * HALF) = w; } }
    }
};

struct EpiXProj { bf16* Q; bf16* KV; const float* gxq; const float* gxk; const float* ss1; LAS float* part;
    __device__ __forceinline__ void operator()(f32x4 (&acc)[2][2][4][2], const Unit& u, int wr, int wc, int fr, int fq) const {
        const bool second = u.pm >= 64; const int pm = second ? u.pm - 64 : u.pm; LAS float* epsrow = part + 2048;
        if (!second && threadIdx.x < 256) { const f32x4* p4 = (const f32x4*)(ss1 + (size_t)(pm * BM + threadIdx.x) * 32); f32x4 a = p4[0];
#pragma unroll
            for (int j = 1; j < 8; ++j) a += p4[j];
            epsrow[threadIdx.x] = EPS * (((a[0] + a[1]) + (a[2] + a[3])) * (1.f / 2048.f) + EPS); }
        if (!second || u.pn < 2) head_norm(acc, part, second ? gxk : gxq, second ? (const LAS float*)nullptr : (const LAS float*)epsrow, wr, wc, fr, fq);
        store_tile_bf16(acc, second ? KV : Q, second ? 1024 : XW, pm * BM + wr * 64 + fr, u.pn * BM + wc * 32 + 8 * fq);
    }
};


struct EpiRes1 { const float* RS0; const float* GM; bf16* X1; float* SS1; const float* SSF; const LAS float* rl;
    __device__ __forceinline__ void mid(f32x4 (&acc)[2][2][4][2], const Unit& u, int wr, int fr, int ui) const {
#pragma unroll
        for (int ai = 0; ai < 2; ++ai)
#pragma unroll
            for (int m = 0; m < 4; ++m) { const float rs = rl[ui * 256 + ai * HALF + wr * 64 + m * 16 + fr];
#pragma unroll
                for (int bj = 0; bj < 2; ++bj) { acc[ai][bj][m][0] *= rs; acc[ai][bj][m][1] *= rs; } }
    }
    __device__ __forceinline__ void operator()(const f32x4 (&acc)[2][2][4][2], const Unit& u, int wr, int wc, int fr, int fq) const {
        int fr_ = fr, fq_ = fq; asm volatile("" : "+v"(fr_), "+v"(fq_));
        const int row0 = u.pm * BM + wr * 64 + fr_, col0 = u.pn * BM + wc * 32 + 8 * fq_;
        f32x4 gi[2][2];
#pragma unroll
        for (int bj = 0; bj < 2; ++bj)
#pragma unroll
            for (int k = 0; k < 2; ++k) { const f32x4 g = *(const f32x4*)(GM + col0 + bj * HALF + 4 * k); gi[bj][k] = (f32x4){1.f / g[0], 1.f / g[1], 1.f / g[2], 1.f / g[3]}; }
        float qs[2][4];
#pragma unroll
        for (int ai = 0; ai < 2; ++ai)
#pragma unroll
            for (int m = 0; m < 4; ++m) qs[ai][m] = RS0[row0 + ai * HALF + m * 16];
#pragma unroll
        for (int ai = 0; ai < 2; ++ai) {
            v4u hw[4][2]; float sq[4] = {0.f, 0.f, 0.f, 0.f};
#pragma unroll
            for (int m = 0; m < 4; ++m) { const int row = row0 + ai * HALF + m * 16;
#pragma unroll
                for (int bj = 0; bj < 2; ++bj) hw[m][bj] = *(const v4u*)(X1 + (size_t)row * DM + col0 + bj * HALF); }
#pragma unroll
            for (int bj = 0; bj < 2; ++bj) {
#pragma unroll
                for (int m = 0; m < 4; ++m) { const int row = row0 + ai * HALF + m * 16; float hf[8]; unpack8(hw[m][bj], hf);
                    const f32x4 v0 = (f32x4){hf[0], hf[1], hf[2], hf[3]} * qs[ai][m] * gi[bj][0] + acc[ai][bj][m][0], v1 = (f32x4){hf[4], hf[5], hf[6], hf[7]} * qs[ai][m] * gi[bj][1] + acc[ai][bj][m][1];
                    sq[m] += (v0[0] * v0[0] + v0[1] * v0[1]) + (v0[2] * v0[2] + v0[3] * v0[3]) + (v1[0] * v1[0] + v1[1] * v1[1]) + (v1[2] * v1[2] + v1[3] * v1[3]);
                    v4u w; w.x = cvt_pk_bf16(v0[0], v0[1]); w.y = cvt_pk_bf16(v0[2], v0[3]); w.z = cvt_pk_bf16(v1[0], v1[1]); w.w = cvt_pk_bf16(v1[2], v1[3]);
                    *(v4u*)(X1 + (size_t)row * DM + col0 + bj * HALF) = w; } }
#pragma unroll
            for (int m = 0; m < 4; ++m) { const int row = row0 + ai * HALF + m * 16; float q = sq[m]; q += __shfl_xor(q, 16); q += __shfl_xor(q, 32);
                if (fq == 0) SS1[(size_t)row * 32 + u.pn * 4 + wc] = q; } }
    }
};
struct EpiRes2 { bf16* X; float* SS2; unsigned char* X8; const float* gmoe;
    __device__ __forceinline__ void operator()(const f32x4 (&acc)[2][2][4][2], const Unit& u, int wr, int wc, int fr, int fq) const {
        const int row0 = u.pm * BM + wr * 64 + fr, col0 = u.pn * BM + wc * 32 + 8 * fq;
        f32x4 gm[2][2];
#pragma unroll
        for (int bj = 0; bj < 2; ++bj) { gm[bj][0] = *(const f32x4*)(gmoe + col0 + bj * HALF); gm[bj][1] = *(const f32x4*)(gmoe + col0 + bj * HALF + 4); }
#pragma unroll
        for (int ai = 0; ai < 2; ++ai) {
            v4u xall[4][2];
#pragma unroll
            for (int m = 0; m < 4; ++m)
#pragma unroll
                for (int bj = 0; bj < 2; ++bj) xall[m][bj] = *(const v4u*)(X + (size_t)(row0 + ai * HALF + m * 16) * DM + col0 + bj * HALF);
#pragma unroll
            for (int m = 0; m < 4; ++m) { const int row = row0 + ai * HALF + m * 16; const size_t off = (size_t)row * DM + col0; float sq = 0.f;
#pragma unroll
                for (int bj = 0; bj < 2; ++bj) { const v4u xw = xall[m][bj];
                    const f32x4 x0 = {lo16(xw.x), hi16(xw.x), lo16(xw.y), hi16(xw.y)}, x1 = {lo16(xw.z), hi16(xw.z), lo16(xw.w), hi16(xw.w)};
                    const f32x4 v0 = x0 + acc[ai][bj][m][0], v1 = x1 + acc[ai][bj][m][1];
                    sq += (v0[0] * v0[0] + v0[1] * v0[1]) + (v0[2] * v0[2] + v0[3] * v0[3]) + (v1[0] * v1[0] + v1[1] * v1[1]) + (v1[2] * v1[2] + v1[3] * v1[3]);
                    v4u w; w.x = cvt_pk_bf16(v0[0], v0[1]); w.y = cvt_pk_bf16(v0[2], v0[3]); w.z = cvt_pk_bf16(v1[0], v1[1]); w.w = cvt_pk_bf16(v1[2], v1[3]);
                    *(v4u*)(X + off + bj * HALF) = w;
                    const f32x4 h0 = v0 * gm[bj][0], h1 = v1 * gm[bj][1]; v2u w8; w8.x = pk4_fp8(h0[0], h0[1], h0[2], h0[3]); w8.y = pk4_fp8(h1[0], h1[1], h1[2], h1[3]);
                    *(v2u*)(X8 + off + bj * HALF) = w8; }
                sq += __shfl_xor(sq, 16); sq += __shfl_xor(sq, 32);
                if (fq == 0) SS2[(size_t)row * 32 + u.pn * 4 + wc] = sq; } }
    }
};
constexpr float W8_SCALE = 64.f, W8_INV = 1.f / 64.f;
__device__ __forceinline__ v4u widen_pair(v2u wa, v2u wb, bool odd) {
    const v2u snd = odd ? wa : wb, kp = odd ? wb : wa; v2u rc; rc.x = (unsigned)__shfl_xor((int)snd.x, 16); rc.y = (unsigned)__shfl_xor((int)snd.y, 16);
    v4u o; if (odd) { o.x = rc.x; o.y = rc.y; o.z = kp.x; o.w = kp.y; } else { o.x = kp.x; o.y = kp.y; o.z = rc.x; o.w = rc.y; } return o;
}
typedef float f32x2 __attribute__((ext_vector_type(2)));
__device__ __forceinline__ f32x2 swiglu_pk(f32x2 g, f32x2 u) {
    g.x = fminf(g.x, SW_LIMIT); g.y = fminf(g.y, SW_LIMIT); u.x = __builtin_amdgcn_fmed3f(u.x, -SW_LIMIT, SW_LIMIT); u.y = __builtin_amdgcn_fmed3f(u.y, -SW_LIMIT, SW_LIMIT);
    const f32x2 a = g * (-SW_ALPHA * 1.4426950408889634f); f32x2 e; e.x = __builtin_amdgcn_exp2f(a.x); e.y = __builtin_amdgcn_exp2f(a.y);
    const f32x2 d = e + 1.0f; f32x2 r; r.x = __builtin_amdgcn_rcpf(d.x); r.y = __builtin_amdgcn_rcpf(d.y);
    return ((u + 1.0f) * g) * r;
}
struct EpiGlu8 { unsigned char* O; const float* bgu; const LAS short* tile_e; const float* rss; const LAS float* rl;
    __device__ __forceinline__ void operator()(const f32x4 (&acc)[2][2][4][2], const Unit& u, int wr, int wc, int fr, int fq, int ui) const {
        const int e = __builtin_amdgcn_readfirstlane(tile_e[u.pm]); const int row0 = u.pm * BM + wr * 64 + fr, col0 = u.pn * HALF + wc * 32 + 8 * fq;
        const float* bg = bgu + (size_t)e * 4096 + col0;
        const f32x4 g0 = *(const f32x4*)bg, g1 = *(const f32x4*)(bg + 4), u0 = *(const f32x4*)(bg + DFF), u1 = *(const f32x4*)(bg + DFF + 4);
        const bool odd = fq & 1;
#pragma unroll
        for (int ai = 0; ai < 2; ++ai) { v2u wm[4];
#pragma unroll
            for (int m = 0; m < 4; ++m) { const int rr = wr * 64 + fr + ai * HALF + m * 16; const float rs = rl[ui * 256 + rr] * W8_INV;
                const f32x4 a0 = acc[ai][0][m][0] * rs + g0, a1 = acc[ai][0][m][1] * rs + g1, b0 = acc[ai][1][m][0] * rs + u0, b1 = acc[ai][1][m][1] * rs + u1;
                const f32x2 s0 = swiglu_pk((f32x2){a0[0], a0[1]}, (f32x2){b0[0], b0[1]}), s1 = swiglu_pk((f32x2){a0[2], a0[3]}, (f32x2){b0[2], b0[3]});
                const f32x2 s2 = swiglu_pk((f32x2){a1[0], a1[1]}, (f32x2){b1[0], b1[1]}), s3 = swiglu_pk((f32x2){a1[2], a1[3]}, (f32x2){b1[2], b1[3]});
                wm[m].x = pk4_fp8(s0.x, s0.y, s1.x, s1.y); wm[m].y = pk4_fp8(s2.x, s2.y, s3.x, s3.y); }
#pragma unroll
            for (int mp = 0; mp < 2; ++mp) { const v4u o = widen_pair(wm[2 * mp], wm[2 * mp + 1], odd);
                *(v4u*)(O + (size_t)(row0 + ai * HALF + (2 * mp + (odd ? 1 : 0)) * 16) * DFF + col0 - (odd ? 8 : 0)) = o; } }
    }
};

constexpr float Y8_SCALE = 8.f, Y8_INV = 1.f / 8.f;
struct EpiBiasFp8 { unsigned char* O; const float* bdn; const LAS short* tile_e;
    __device__ __forceinline__ void operator()(const f32x4 (&acc)[2][2][4][2], const Unit& u, int wr, int wc, int fr, int fq, int) const {
        const int e = __builtin_amdgcn_readfirstlane(tile_e[u.pm]); const int row0 = u.pm * BM + wr * 64 + fr, col0 = u.pn * BM + wc * 32 + 8 * fq;
        const float* bb = bdn + (size_t)e * DM + col0; f32x4 bv[2][2];
#pragma unroll
        for (int bj = 0; bj < 2; ++bj) { bv[bj][0] = *(const f32x4*)(bb + bj * HALF) * Y8_SCALE; bv[bj][1] = *(const f32x4*)(bb + bj * HALF + 4) * Y8_SCALE; }
        const bool odd = fq & 1;
#pragma unroll
        for (int ai = 0; ai < 2; ++ai)
#pragma unroll
            for (int bj = 0; bj < 2; ++bj) { v2u wm[4];
#pragma unroll
                for (int m = 0; m < 4; ++m) { const f32x4 v0 = acc[ai][bj][m][0] * (W8_INV * Y8_SCALE) + bv[bj][0], v1 = acc[ai][bj][m][1] * (W8_INV * Y8_SCALE) + bv[bj][1];
                    wm[m].x = pk4_fp8(v0[0], v0[1], v0[2], v0[3]); wm[m].y = pk4_fp8(v1[0], v1[1], v1[2], v1[3]); }
#pragma unroll
                for (int mp = 0; mp < 2; ++mp) { const v4u o = widen_pair(wm[2 * mp], wm[2 * mp + 1], odd);
                    *(v4u*)(O + (size_t)(row0 + ai * HALF + (2 * mp + (odd ? 1 : 0)) * 16) * DM + col0 + bj * HALF - (odd ? 8 : 0)) = o; } }
    }
};

struct DualOrder { int n1, nN1, n2, nN2, pm_split, G, c; const char* A1; const char* B1; const char* A2; const char* B2; size_t tstep;
    __device__ bool next(int i, Unit& u) const { const int L = i * G + c; if (L >= n1 + n2) return false;
        if (L < n1) { u.pm = L / nN1; u.pn = L % nN1; u.A = A1 + (size_t)u.pm * tstep; u.B = B1 + (size_t)u.pn * tstep; }
        else { const int l = L - n1; const int pm = l / nN2; u.pn = l % nN2; u.pm = pm + pm_split; u.A = A2 + (size_t)pm * tstep; u.B = B2 + (size_t)u.pn * tstep; }
        return true; }
    __device__ __forceinline__ int row(int) const { return 0; }
};
struct MoeOrder { int nU, nN, G, c; const char* A; const char* B; size_t estride, tstep; const LAS short* tile_e; const int* list; bool gather;
    __device__ bool next(int i, Unit& u) const { const int L = i * G + c; if (L >= nU) return false;
        u.pm = L / nN; u.pn = L % nN; const int e = __builtin_amdgcn_readfirstlane(tile_e[u.pm]); u.A = gather ? A : A + (size_t)u.pm * tstep; u.B = B + (size_t)e * estride + (size_t)u.pn * tstep; return true; }
    __device__ __forceinline__ int row(int r) const { return list[r]; }
};
}


namespace fa {
constexpr int D = 128, NW = 8, QBLK = 32, KVBLK = 64, QB = NW * QBLK;
constexpr int SHM_V = KVBLK * D * 2, SHM_K = KVBLK * D * 2;
constexpr int BIAS_OFF = 2 * SHM_V + 2 * SHM_K + NW * 64 * 4;
constexpr int LDS_BYTES = BIAS_OFF + 2048 * 4;
constexpr int SSQ_OFF = 81920;
constexpr float SCALE = 0.08838834764831845f, THR = 8.f;
typedef short s16x4 __attribute__((ext_vector_type(4)));
typedef unsigned u32x4 __attribute__((ext_vector_type(4)));
#define KSWZ(row, colB) ((row) * 256 + ((colB) ^ (((row) & 7) << 4)))
#define SBAR() __builtin_amdgcn_sched_barrier(0)
__device__ __forceinline__ int v_st(int k, int c) { const int kk = (k & ~0xC) | ((k & 4) << 1) | ((k & 8) >> 1); return ((kk >> 3) * 4 + (c >> 5)) * 512 + ((kk & 7) * 32 + (c & 31)) * 2; }
__device__ __forceinline__ int v_rd_base(int lane) { return ((lane & 3) << 3) | (((lane >> 2) & 3) << 6) | (((lane >> 4) & 1) << 5) | (((lane >> 5) & 1) << 8); }
constexpr int v_rd_off(int d0, int ks, int half) { return d0 * 512 + ks * 4096 + half * 2048; }
__device__ __forceinline__ int crow(int r, int hi) { return (r & 3) + 8 * (r >> 2) + 4 * hi; }
__device__ __forceinline__ unsigned cvtpk(float lo, float hi) { unsigned r; asm volatile("v_cvt_pk_bf16_f32 %0, %1, %2" : "=v"(r) : "v"(lo), "v"(hi)); return r; }
__device__ __forceinline__ bf16x8 load8(const bf16* p) { return *reinterpret_cast<const bf16x8*>(p); }
__device__ __forceinline__ void mask_tile(f32x16& p0, f32x16& p1, int dq, unsigned W) {
    const float NEG = -__builtin_inff();
#pragma unroll
    for (int r = 0; r < 16; ++r) { const int c = (r & 3) + 8 * (r >> 2);
        if ((unsigned)(dq - c) >= W) p0[r] = NEG;
        if ((unsigned)(dq - c - 32) >= W) p1[r] = NEG; }
}
__device__ __forceinline__ void partialSM(f32x16& p0, f32x16& p1, float& m_reg, float& mn, float& alpha) {
    float pmax = p0[0]; for (int r = 1; r < 16; ++r) pmax = fmaxf(pmax, p0[r]); for (int r = 0; r < 16; ++r) pmax = fmaxf(pmax, p1[r]);
    { auto rr = __builtin_amdgcn_permlane32_swap(__float_as_uint(pmax), __float_as_uint(pmax), false, false);
      pmax = fmaxf(__uint_as_float(rr[0]), __uint_as_float(rr[1])); }
    constexpr float C2 = 1.4426950408889634f * SCALE;
    if (__builtin_expect(__all((pmax - m_reg) * SCALE <= THR), 1)) { mn = m_reg; alpha = 1.f; }
    else { mn = fmaxf(m_reg, pmax); alpha = __builtin_amdgcn_exp2f((m_reg - mn) * C2); m_reg = mn; }
    const float mnL = -mn * C2;
    for (int r = 0; r < 16; ++r) p0[r] = fmaf(p0[r], C2, mnL); for (int r = 0; r < 16; ++r) p1[r] = fmaf(p1[r], C2, mnL);
    for (int r = 0; r < 16; ++r) p0[r] = __builtin_amdgcn_exp2f(p0[r]);
}
__device__ __forceinline__ void finishSM(f32x16& p0, f32x16& p1, float alpha, float& l_reg, bf16x8& pa0, bf16x8& pa1, bf16x8& pa2, bf16x8& pa3) {
    for (int r = 0; r < 16; ++r) p1[r] = __builtin_amdgcn_exp2f(p1[r]);
    float ps = 0; for (int r = 0; r < 16; ++r) ps += p0[r]; for (int r = 0; r < 16; ++r) ps += p1[r];
    { auto rr = __builtin_amdgcn_permlane32_swap(__float_as_uint(ps), __float_as_uint(ps), false, false);
      ps = __uint_as_float(rr[0]) + __uint_as_float(rr[1]); }
    l_reg = l_reg * alpha + ps;
#define PK4(P, B_, OUT) do { unsigned a0 = cvtpk(P[B_+0], P[B_+1]), a1 = cvtpk(P[B_+2], P[B_+3]);                          \
        unsigned b0 = cvtpk(P[B_+4], P[B_+5]), b1 = cvtpk(P[B_+6], P[B_+7]);                                             \
        auto r0 = __builtin_amdgcn_permlane32_swap(a0, b0, false, false); auto r1 = __builtin_amdgcn_permlane32_swap(a1, b1, false, false); \
        u32x4 w = {r0[0], r1[0], r0[1], r1[1]}; OUT = *reinterpret_cast<bf16x8*>(&w); } while (0)
    PK4(p0, 0, pa0); PK4(p0, 8, pa1); PK4(p1, 0, pa2); PK4(p1, 8, pa3);
#undef PK4
}
template <int KB, bool BIAS>
__device__ __forceinline__ void qkt(f32x16& p0, f32x16& p1, const char* K_lds, const char* bias_t, int r32, int hi, const bf16x8* qr) {
    if constexpr (BIAS) {
#pragma unroll
        for (int g = 0; g < 4; ++g) { const f32x4 a = *reinterpret_cast<const f32x4*>(bias_t + (8 * g) * 4), b = *reinterpret_cast<const f32x4*>(bias_t + (32 + 8 * g) * 4);
            p0[4 * g] = a[0]; p0[4 * g + 1] = a[1]; p0[4 * g + 2] = a[2]; p0[4 * g + 3] = a[3]; p1[4 * g] = b[0]; p1[4 * g + 1] = b[1]; p1[4 * g + 2] = b[2]; p1[4 * g + 3] = b[3]; }
    } else { p0 = f32x16{}; p1 = f32x16{}; }
    const char* kb[4];
#pragma unroll
    for (int dd = 0; dd < 4; ++dd) kb[dd] = K_lds + KB * SHM_K + KSWZ(r32, (dd * 16 + hi * 8) * 2);
#pragma unroll
    for (int d0 = 0; d0 < 8; ++d0) { const char* a = kb[d0 & 3] + (d0 >> 2) * 128;
        bf16x8 b0 = *reinterpret_cast<const bf16x8*>(a);
        bf16x8 b1 = *reinterpret_cast<const bf16x8*>(a + 32 * 256);
        p0 = __builtin_amdgcn_mfma_f32_32x32x16_bf16(b0, qr[d0], p0, 0, 0, 0);
        p1 = __builtin_amdgcn_mfma_f32_32x32x16_bf16(b1, qr[d0], p1, 0, 0, 0); }
}
template <int VB>
__device__ __forceinline__ void pv_tile(f32x16* o, int vb0, bf16x8 pa0, bf16x8 pa1, bf16x8 pa2, bf16x8 pa3) {
#define TRRD(dst, off) asm volatile("ds_read_b64_tr_b16 %0, %1 offset:%2" : "=&v"(dst) : "v"(vb0), "i"(off) : "memory")
#define PV_D0(d0) do { s16x4 l0, l1, l2, l3, h0, h1, h2, h3; constexpr int b_ = VB * SHM_V + v_rd_off(d0, 0, 0); \
        TRRD(l0, b_); TRRD(h0, b_ + 2048); TRRD(l1, b_ + 4096); TRRD(h1, b_ + 6144); TRRD(l2, b_ + 8192); TRRD(h2, b_ + 10240); TRRD(l3, b_ + 12288); TRRD(h3, b_ + 14336); \
        asm volatile("s_waitcnt lgkmcnt(0)" ::: "memory"); SBAR();   \
        o[d0] = __builtin_amdgcn_mfma_f32_32x32x16_bf16(pa0, (bf16x8){l0[0], l0[1], l0[2], l0[3], h0[0], h0[1], h0[2], h0[3]}, o[d0], 0, 0, 0);   \
        o[d0] = __builtin_amdgcn_mfma_f32_32x32x16_bf16(pa1, (bf16x8){l1[0], l1[1], l1[2], l1[3], h1[0], h1[1], h1[2], h1[3]}, o[d0], 0, 0, 0);   \
        o[d0] = __builtin_amdgcn_mfma_f32_32x32x16_bf16(pa2, (bf16x8){l2[0], l2[1], l2[2], l2[3], h2[0], h2[1], h2[2], h2[3]}, o[d0], 0, 0, 0);   \
        o[d0] = __builtin_amdgcn_mfma_f32_32x32x16_bf16(pa3, (bf16x8){l3[0], l3[1], l3[2], l3[3], h3[0], h3[1], h3[2], h3[3]}, o[d0], 0, 0, 0); } while (0)
    PV_D0(0); PV_D0(1); PV_D0(2); PV_D0(3);
#undef PV_D0
#undef TRRD
}
struct BlockRef { const bf16* Q; const bf16* K; const bf16* V; bf16* O; int P0; };
struct Seam { bf16x8 qr[8]; bf16x8 st_v0, st_v1, st_k0, st_k1; };
__device__ __forceinline__ int swa_jlo(int P0, int W) { const int lowk = P0 - W + 1; return lowk > 0 ? lowk / KVBLK : 0; }
#define ROW(p, k0, rr) ((p) + (size_t)((k0) + (rr)) * KP + sc)
#define VMW() asm volatile("s_waitcnt vmcnt(0)" ::: "memory")
#define VMWN(n) asm volatile("s_waitcnt vmcnt(%0)" :: "i"(n) : "memory")
#define SLOAD_H(Kp, Vp, k0) do { S.st_v0 = load8(ROW(Vp, k0, sr)); S.st_v1 = load8(ROW(Vp, k0, 32 + sr));              \
                         S.st_k0 = load8(ROW(Kp, k0, sr)); S.st_k1 = load8(ROW(Kp, k0, 32 + sr)); } while (0)
#define SWRITE_HK(bf) do { *(bf16x8*)(K_lds + (bf) * SHM_K + kws) = S.st_k0; *(bf16x8*)(K_lds + (bf) * SHM_K + kws + 32 * 256) = S.st_k1; } while (0)
#define SWRITE_HV(bf) do { *(bf16x8*)(V_lds + (bf) * SHM_V + vst0) = S.st_v0; *(bf16x8*)(V_lds + (bf) * SHM_V + vst1) = S.st_v1; } while (0)
#define SWRITE_H(bf) do { SWRITE_HV(bf); SWRITE_HK(bf); } while (0)
template <int QP, int KP>
__device__ __forceinline__ void prime(const BlockRef& cur, int W, char* lds, Seam& S) {
    const int tid = threadIdx.x, wid = __builtin_amdgcn_readfirstlane(tid >> 6), lane = tid & 63, r32 = lane & 31, hi = lane >> 5;
    const int sr = tid >> 4, sc = (tid & 15) * 8, kws = KSWZ(sr, sc * 2); char* K_lds = lds + 2 * SHM_V;
    const int kb0 = swa_jlo(cur.P0, W) * KVBLK;
    for (int d0 = 0; d0 < 8; ++d0) S.qr[d0] = load8(cur.Q + (size_t)(wid * QBLK + r32) * QP + d0 * 16 + hi * 8);
    SLOAD_H(cur.K, cur.V, kb0); VMW(); SWRITE_HK(0);
    __syncthreads();
}
template <int QP, int KP, int OP, bool BIAS, bool CAUSAL, bool SSQ>
__device__ __forceinline__ void block(const BlockRef& cur, const BlockRef& nxt, int skv, int W, char* lds, Seam& S, const bf16* obase = nullptr, float* ssbase = nullptr) {
    const int tid = threadIdx.x, wid = __builtin_amdgcn_readfirstlane(tid >> 6), lane = tid & 63, r32 = lane & 31, hi = lane >> 5;
    const int j_lo = swa_jlo(cur.P0, W);
    int j_hi = (cur.P0 + QB - 1) / KVBLK + 1; if (j_hi > skv / KVBLK) j_hi = skv / KVBLK;
    const int NT = j_hi - j_lo;
    const int kbn = swa_jlo(nxt.P0, W) * KVBLK;
    const int qlo = cur.P0 + wid * QBLK, qm = qlo + r32 - 4 * hi;
    char* V_lds = lds; char* K_lds = lds + 2 * SHM_V;
    float* ws = (float*)(lds + 2 * SHM_V + 2 * SHM_K) + wid * 64; float* li_l = ws, * al_l = ws + 32;
    const char* bias_l = lds + BIAS_OFF + hi * 16;
    float m_reg = -1e30f, l_reg = 0; f32x16 o[4] = {};
    const int sr = tid >> 4, sc = (tid & 15) * 8, vst0 = v_st(sr, sc), vst1 = v_st(32 + sr, sc), kws = KSWZ(sr, sc * 2);
    const int vb0 = (int)(uintptr_t)V_lds + v_rd_base(lane);
    const bf16* Kh = cur.K; const bf16* Vh = cur.V;
#define RESC(a) do { if (__any((a) < 1.f)) { if (hi == 0) al_l[r32] = (a); asm volatile("s_waitcnt lgkmcnt(0)" ::: "memory");              \
                     for (int d_ = 0; d_ < 4; ++d_) for (int r = 0; r < 16; ++r) o[d_][r] *= al_l[crow(r, hi)]; } } while (0)
#define KBASE(t) ((j_lo + (t)) * KVBLK)
#define BIAS_T(t) (bias_l + KBASE(t) * 4)
#define MASKT(P0_, P1_, t) do { if constexpr (CAUSAL) { const int kb_ = KBASE(t); if (kb_ + KVBLK - 1 > qlo || kb_ <= qlo + QBLK - 1 - W) mask_tile(P0_, P1_, qm - kb_, (unsigned)W); } } while (0)
    constexpr int NQL = 8;
#define SEAM_K0() do { VMWN(NQL); SWRITE_HK(0); SBAR(); } while (0)
    f32x16 pA0, pA1, pB0, pB1; float mnA, mnB, alA, alB; bf16x8 pa0, pa1, pa2, pa3;
    SWRITE_HV(0); SBAR();
    if (NT > 1) { SLOAD_H(Kh, Vh, KBASE(1)); }
    SBAR(); qkt<0, BIAS>(pA0, pA1, K_lds, BIAS_T(0), r32, hi, S.qr);
    MASKT(pA0, pA1, 0); partialSM(pA0, pA1, m_reg, mnA, alA);
    if (NT > 1) { VMW(); SWRITE_H(1); }
    __syncthreads();
#define HALF_STEP(PX0, PX1, mnX, alX, PY0, PY1, alY, t, KB, VB, SB) do {                                                      \
        SBAR(); qkt<KB, BIAS>(PX0, PX1, K_lds, BIAS_T(t), r32, hi, S.qr);                                                    \
        finishSM(PY0, PY1, alY, l_reg, pa0, pa1, pa2, pa3); SBAR();                                                           \
        if ((t) + 1 < NT) { SLOAD_H(Kh, Vh, KBASE((t) + 1)); SBAR(); }                                                        \
        pv_tile<VB>(o, vb0, pa0, pa1, pa2, pa3); MASKT(PX0, PX1, (t)); partialSM(PX0, PX1, m_reg, mnX, alX);                   \
        __syncthreads();                                                                                                      \
        if ((t) + 1 < NT) { VMW(); SWRITE_H(SB); }                                                                           \
        RESC(alX); __syncthreads(); } while (0)
    for (int t = 1; t + 1 < NT; t += 2) {
        HALF_STEP(pB0, pB1, mnB, alB, pA0, pA1, alA, t, 1, 0, 0);
        HALF_STEP(pA0, pA1, mnA, alA, pB0, pB1, alB, t + 1, 0, 1, 1);
    }
    const bool even = (NT & 1) == 0;
    if (even) { SBAR(); qkt<1, BIAS>(pB0, pB1, K_lds, BIAS_T(NT - 1), r32, hi, S.qr); SBAR(); }
    SLOAD_H(nxt.K, nxt.V, kbn); SBAR();
#pragma unroll
    for (int d0 = 0; d0 < 8; ++d0) S.qr[d0] = load8(nxt.Q + (size_t)(wid * QBLK + r32) * QP + d0 * 16 + hi * 8);
    SBAR();
    finishSM(pA0, pA1, alA, l_reg, pa0, pa1, pa2, pa3); SBAR();
    pv_tile<0>(o, vb0, pa0, pa1, pa2, pa3);
    if (even) { MASKT(pB0, pB1, NT - 1); partialSM(pB0, pB1, m_reg, mnB, alB); __syncthreads(); RESC(alB);
        finishSM(pB0, pB1, alB, l_reg, pa0, pa1, pa2, pa3); SBAR(); pv_tile<1>(o, vb0, pa0, pa1, pa2, pa3); }
    SBAR(); SEAM_K0();
    if (hi == 0) li_l[r32] = l_reg; asm volatile("s_waitcnt lgkmcnt(0)" ::: "memory");
    float rli[16];
#pragma unroll
    for (int r = 0; r < 16; ++r) rli[r] = __builtin_amdgcn_rcpf(li_l[crow(r, hi)]);
    bf16* Ow = cur.O + (size_t)(wid * QBLK) * OP;
#pragma unroll
    for (int r = 0; r < 16; ++r) { const int orow = crow(r, hi); float sq = 0.f;
#pragma unroll
        for (int d0 = 0; d0 < 4; ++d0) { const float v = o[d0][r] * rli[r]; sq += v * v;
            const float vn = __shfl_xor(v, 1);
            if ((r32 & 1) == 0) *(unsigned*)(Ow + (size_t)orow * OP + d0 * 32 + r32) = cvtpk(v, vn); }
        if constexpr (SSQ) ((float*)(lds + SSQ_OFF))[(wid * 32 + hi * 16 + r) * 32 + r32] = sq; }
    if constexpr (SSQ) { const int L_ = lane & 31, hi_ = (L_ >> 2) & 1, r_ = (L_ & 3) + 4 * (L_ >> 3);
        const f32x4* p_ = (const f32x4*)((const float*)(lds + SSQ_OFF) + (wid * 32 + hi_ * 16 + r_) * 32); f32x4 a_ = p_[0];
#pragma unroll
        for (int j_ = 1; j_ < 8; ++j_) a_ += p_[j_];
        if (lane < 32) { const size_t idx_ = (size_t)(cur.O - obase); ssbase[(idx_ / OP + wid * QBLK + L_) * 8 + (idx_ % OP) / D] = (a_[0] + a_[1]) + (a_[2] + a_[3]); } }
    __syncthreads();
#undef RESC
#undef KBASE
#undef BIAS_T
#undef MASKT
#undef SEAM_K0
#undef HALF_STEP
}
#undef ROW
#undef VMW
#undef VMWN
#undef SLOAD_H
#undef SWRITE_HK
#undef SWRITE_HV
#undef SWRITE_H
#undef KSWZ
#undef SBAR
}


struct CvTile { const float* W; unsigned char* WT; int ldw, k0, n0, gu; };
__device__ __forceinline__ CvTile cv_decode(const Frame& F, int tile) {
    constexpr int TGU = 16 * 16, TDN = 16 * 8; CvTile t;
    if (tile < NE * TGU) { const int e = tile / TGU, q = tile % TGU; t.W = F.in[I_WGU] + (size_t)e * DM * 4096; t.WT = F.ws + WS_WGU + (size_t)e * 4096 * DM; t.ldw = 4096; t.k0 = (q >> 4) * 128; t.n0 = (q & 15) * 256; t.gu = 1; }
    else { const int r = tile - NE * TGU, e = r / TDN, q = r % TDN; t.W = F.in[I_WDN] + (size_t)e * DFF * DM; t.WT = F.ws + WS_WDN + (size_t)e * DM * DFF; t.ldw = DM; t.k0 = (q >> 3) * 128; t.n0 = (q & 7) * 256; t.gu = 0; }
    return t;
}
__device__ __forceinline__ void p0_moe_convert8(Frame& F) {
    constexpr int NTILES = NE * (16 * 16 + 16 * 8);
    LAS unsigned char* L = F.lds; LAS unsigned char* T8 = L + 131072; const int tid = F.tid, lane = F.lane, w = F.wave;
    const int bx = blockIdx.x; if (bx >= NTILES) return;
    const int nhalf = 2 * ((NTILES - bx + F.G - 1) / F.G);
#define CV_DMA(i_) do { const CvTile t_ = cv_decode(F, bx + ((i_) >> 1) * F.G); const float* p_ = t_.W + (size_t)(t_.k0 + 64 * ((i_) & 1) + 8 * w) * t_.ldw + t_.n0 + 4 * lane; \
        _Pragma("unroll") for (int q_ = 0; q_ < 8; ++q_) __builtin_amdgcn_global_load_lds((const unsigned*)(p_ + (size_t)q_ * t_.ldw), (LAS unsigned*)(L + ((i_) & 1) * 65536 + (8 * w + q_) * 1024), 16, 0, 2); } while (0)
    CV_DMA(0); if (nhalf > 1) CV_DMA(1);
    for (int i = 0; i < nhalf; ++i) {
        if (i + 1 < nhalf) { if (i == 0) asm volatile("s_waitcnt vmcnt(8)" ::: "memory"); else asm volatile("s_waitcnt vmcnt(10)" ::: "memory"); }
        else { if (i == 0) asm volatile("s_waitcnt vmcnt(0)" ::: "memory"); else asm volatile("s_waitcnt vmcnt(2)" ::: "memory"); }
        __builtin_amdgcn_s_barrier(); asm volatile("" ::: "memory");
        { const LAS float* src = (const LAS float*)(L + (i & 1) * 65536); const int n = tid & 255, kh = tid >> 8; unsigned d[8];
#pragma unroll
          for (int q = 0; q < 8; ++q) { const LAS float* s4 = src + (kh * 32 + 4 * q) * 256 + n; d[q] = pg8::pk4_fp8(s4[0] * 64.f, s4[256] * 64.f, s4[512] * 64.f, s4[768] * 64.f); }
          const int sw = (n >> 1) & 3;
          *(LAS bf16x8*)(T8 + n * 64 + (((2 * kh) ^ sw) * 16)) = __builtin_bit_cast(bf16x8, (v4u){d[0], d[1], d[2], d[3]});
          *(LAS bf16x8*)(T8 + n * 64 + (((2 * kh + 1) ^ sw) * 16)) = __builtin_bit_cast(bf16x8, (v4u){d[4], d[5], d[6], d[7]}); }
        asm volatile("s_waitcnt lgkmcnt(0)" ::: "memory"); __builtin_amdgcn_s_barrier(); asm volatile("" ::: "memory");
        { const CvTile t = cv_decode(F, bx + (i >> 1) * F.G); const int kb = t.k0 + 64 * (i & 1);
#pragma unroll
          for (int j = 0; j < 2; ++j) { const int p = tid + 512 * j, n = p >> 2, c = p & 3; const bf16x8 v = *(const LAS bf16x8*)(T8 + n * 64 + ((c ^ ((n >> 1) & 3)) * 16)); const int nn = t.n0 + n;
              const int dr = t.gu ? ((nn & 2047) >> 7) * 256 + (nn >> 11) * 128 + (nn & 127) : nn;
              __builtin_nontemporal_store(__builtin_bit_cast(v4u, v), (v4u*)(t.WT + (size_t)dr * 2048 + kb + c * 16)); } }
        if (i + 2 < nhalf) CV_DMA(i + 2);
    }
    asm volatile("s_waitcnt vmcnt(0)" ::: "memory");
#undef CV_DMA
}

constexpr int NPH = 14;

__device__ __forceinline__ void p0_prologue(Frame& F) {
    const float* x = F.in[I_X]; const float* wmi = F.in[I_WMIXIN];
    LAS float* wf = (LAS float*)(F.lds + 73728);
    { f32x4 wl[4][2];
#pragma unroll
      for (int q = 0; q < 4; ++q) { const f32x4* p = (const f32x4*)(wmi + (size_t)(F.tid + 512 * q) * MIXIN + NPROJ); wl[q][0] = p[0]; wl[q][1] = p[1]; }
#pragma unroll
      for (int q = 0; q < 4; ++q) { const int d = F.tid + 512 * q;
#pragma unroll
          for (int hh = 0; hh < 8; ++hh) wf[hh * 2048 + d] = wl[q][hh >> 2][hh & 3]; } }
    __syncthreads();
    bf16* hbf = (bf16*)(F.ws + WS_HBF); float* logf = (float*)(F.ws + WS_LOGF);
    {
        const int lane = F.lane; const f32x4* gr = (const f32x4*)F.in[I_GMIX] + lane; float* rs0 = (float*)(F.ws + WS_RSTD2);
        f32x4 a[8], b[8], na[8], nb[8], gv[8];
#pragma unroll
        for (int j = 0; j < 8; ++j) gv[j] = gr[64 * j];
        const float bf_ = F.in[I_BFORGET][lane & 7];
        int m = F.gw;
        if (m < T) {
#pragma unroll
            for (int j = 0; j < 8; ++j) { a[j] = ((const f32x4*)(x + (size_t)m * DM) + lane)[64 * j]; b[j] = ((const f32x4*)(x + (size_t)(m + F.NGW < T ? m + F.NGW : m) * DM) + lane)[64 * j]; }
        }
#pragma unroll 1
        for (; m < T; m += 2 * F.NGW) {
            const bool two = m + F.NGW < T; const int mn = m + 2 * F.NGW; const bool more = mn < T;
            if (more) { const int mn2 = mn + F.NGW < T ? mn + F.NGW : mn;
#pragma unroll
                for (int j = 0; j < 8; ++j) { na[j] = ((const f32x4*)(x + (size_t)mn * DM) + lane)[64 * j]; nb[j] = ((const f32x4*)(x + (size_t)mn2 * DM) + lane)[64 * j]; } }
            float sa = 0.f, sb = 0.f;
#pragma unroll
            for (int j = 0; j < 8; ++j) { sa += (a[j].x * a[j].x + a[j].y * a[j].y) + (a[j].z * a[j].z + a[j].w * a[j].w); sb += (b[j].x * b[j].x + b[j].y * b[j].y) + (b[j].z * b[j].z + b[j].w * b[j].w); }
            const float qa = sqrtf(wave_sum(sa) * (1.f / 2048.f) + EPS), qb = sqrtf(wave_sum(sb) * (1.f / 2048.f) + EPS); const float ra = 1.f / qa, rb = 1.f / qb;
            if (lane == 0) { rs0[m] = qa; if (two) rs0[m + F.NGW] = qb; }
            v2u* oa = (v2u*)(hbf + (size_t)m * DM) + lane; v2u* ob = (v2u*)(hbf + (size_t)(m + F.NGW) * DM) + lane;
#pragma unroll
            for (int j = 0; j < 8; ++j) { const f32x4 g = gv[j]; a[j] = a[j] * ra * g; b[j] = b[j] * rb * g;
                v2u w; w.x = pk2(a[j].x, a[j].y); w.y = pk2(a[j].z, a[j].w); oa[64 * j] = w;
                if (two) { w.x = pk2(b[j].x, b[j].y); w.y = pk2(b[j].z, b[j].w); ob[64 * j] = w; } }
            float za = 0.f, zb = 0.f;
#pragma unroll 1
            for (int hh = 0; hh < 8; ++hh) { float s0 = 0.f, s1 = 0.f;
#pragma unroll
                for (int j = 0; j < 8; ++j) { const f32x4 w = *(const LAS f32x4*)(wf + hh * 2048 + 4 * (lane + 64 * j)); s0 += (a[j].x * w.x + a[j].y * w.y) + (a[j].z * w.z + a[j].w * w.w); s1 += (b[j].x * w.x + b[j].y * w.y) + (b[j].z * w.z + b[j].w * w.w); }
                s0 = wave_sum(s0); s1 = wave_sum(s1); za = (lane == hh) ? s0 : za; zb = (lane == hh) ? s1 : zb; }
            if (lane < 8) { logf[(size_t)m * 8 + lane] = log_sigmoid(za + bf_); if (two) logf[(size_t)(m + F.NGW) * 8 + lane] = log_sigmoid(zb + bf_); }
            if (more) {
#pragma unroll
                for (int j = 0; j < 8; ++j) { a[j] = na[j]; b[j] = nb[j]; } }
        }
    }
    {
        LAS float* scr = (LAS float*)(F.lds + F.wave * 8704);
        constexpr int IT_MI = 32 * 192;
        for (int r = F.gw; r < IT_MI; r += F.NGW) { const int n0 = 32 * (r % 192); int drow0 = n0;
            if (n0 >= 1024 && n0 < 3072) { const int ux = n0 >= 2048, c = n0 - (ux ? 2048 : 1024); drow0 = (4 + (c >> 7)) * 256 + ux * 128 + (c & 127); }
            transpose_item(F.in[I_WMIXIN], MIXIN, DM, 64 * (r / 192), n0, (bf16*)(F.ws + WS_WMIXIN), drow0, scr, F.lane, 64 * (r / 192), nullptr); }
    }
    { float* wrg = (float*)(F.ws + WS_WRG); const int gt = blockIdx.x * NTHREADS + F.tid;
      for (int i = gt; i < DM * NE; i += F.G * NTHREADS) wrg[i] = F.in[I_WROUTER][i] * F.in[I_GMOE][i >> 5]; }
}


__device__ __forceinline__ void late_work(Frame& F) {
    bf16* memn = (bf16*)(F.ws + WS_MEMN);
    for (int m = F.gw; m < MROWS; m += F.NGW) { f32x4 v[8]; rms_row_2048(F.in[I_MEM] + (size_t)m * DM, F.in[I_GMEM], memn + (size_t)m * DM, F.lane, v); }
    { const float* logf = (const float*)(F.ws + WS_LOGF); float* biasS = (float*)(F.ws + WS_BIAS); const int lane = F.lane;
    if (F.gw < BATCH * FH) {
        const int b = F.gw >> 3, h = F.gw & 7; float loc[32]; float run = 0.f;
#pragma unroll
        for (int i = 0; i < 32; ++i) { run += logf[((size_t)b * SEQ + lane * 32 + i) * 8 + h]; loc[i] = run; }
        float incl = run;
#pragma unroll
        for (int o = 1; o < 64; o <<= 1) { const float t = __shfl_up(incl, o); if (lane >= o) incl += t; }
        const float excl = incl - run;
#pragma unroll
        for (int i = 0; i < 32; ++i) biasS[(size_t)F.gw * SEQ + lane * 32 + i] = -(excl + loc[i]) * (1.f / ATT_SCALE);
    }
    }
    {   LAS float* scr = (LAS float*)(F.lds + F.wave * 8704);
        constexpr int IT_MO = 32 * 64, IT_XQ = 32 * 16, IT_XKV = 32 * 32, IT_XO = 8 * 64;
        constexpr int NITEMS = IT_MO + IT_XQ + IT_XKV + IT_XO;
        for (int it = F.gw; it < NITEMS; it += F.NGW) {
            int r = it;
            if (r < IT_MO) { const int k0 = 64 * (r / 64);
                transpose_item(F.in[I_WMIXOUT], DM, DM, k0, 32 * (r % 64), (bf16*)(F.ws + WS_WMIXOUT), 32 * (r % 64), scr, F.lane, (k0 + 1024) & 2047, k0 >= 1024 ? F.in[I_GFOX] + (k0 - 1024) : nullptr); continue; } r -= IT_MO;
            if (r < IT_XQ) { transpose_item(F.in[I_WXQ], XW, DM, 64 * (r / 16), 32 * (r % 16), (bf16*)(F.ws + WS_WXQ), 32 * (r % 16), scr, F.lane, 64 * (r / 16), F.in[I_GXATTN] + 64 * (r / 16)); continue; } r -= IT_XQ;
            if (r < IT_XKV) { transpose_item(F.in[I_WXKV], 1024, DM, 64 * (r / 32), 32 * (r % 32), (bf16*)(F.ws + WS_WXKV), 32 * (r % 32), scr, F.lane, 64 * (r / 32), nullptr); continue; } r -= IT_XKV;
            { transpose_item(F.in[I_WXO], DM, XW, 64 * (r / 64), 32 * (r % 64), (bf16*)(F.ws + WS_WXO), 32 * (r % 64), scr, F.lane, 64 * (r / 64), nullptr); }
        }
    }
    __syncthreads();
    p0_moe_convert8(F);
    __syncthreads();
}

struct P2Row { v4u ub[2], c0[2], c1[2], c2[2]; float m1, m2; };
__device__ __forceinline__ void p2_load(P2Row& R, const bf16* proj, int t, int lane) {
    const bf16* pr = proj + (size_t)t * NPROJ; const int s = t & (SEQ - 1), ch = lane * 16;
    const bf16* pr1 = (s >= 1) ? pr - NPROJ : pr; const bf16* pr2 = (s >= 2) ? pr - 2 * NPROJ : pr;
    R.m1 = (s >= 1) ? 1.f : 0.f; R.m2 = (s >= 2) ? 1.f : 0.f;
#pragma unroll
    for (int hb = 0; hb < 2; ++hb) { const int c = ch + hb * 8;
        R.ub[hb] = *(const v4u*)(pr + c); R.c0[hb] = *(const v4u*)(pr + 1024 + c); R.c1[hb] = *(const v4u*)(pr1 + 1024 + c); R.c2[hb] = *(const v4u*)(pr2 + 1024 + c); }
}
__device__ __forceinline__ void p2_finish(const P2Row& R, const float (&cw)[3][16], const float (&gconv)[16], bf16* ymix, int t, int lane) {
    const int ch = lane * 16; float y[16]; float ss = 0.f;
#pragma unroll
    for (int hb = 0; hb < 2; ++hb) { float ub[8], a[8], a1[8], a0[8];
        unpack8(R.ub[hb], ub); unpack8(R.c0[hb], a); unpack8(R.c1[hb], a1); unpack8(R.c2[hb], a0);
#pragma unroll
        for (int i = 0; i < 8; ++i) { const float v = ub[i] * (cw[0][hb * 8 + i] * R.m2 * a0[i] + cw[1][hb * 8 + i] * R.m1 * a1[i] + cw[2][hb * 8 + i] * a[i]); y[hb * 8 + i] = v; ss += v * v; } }
    const float rstd = 1.f / sqrtf(wave_sum(ss) * (1.f / 1024.f) + EPS);
#pragma unroll
    for (int hb = 0; hb < 2; ++hb) { float o[8];
#pragma unroll
        for (int i = 0; i < 8; ++i) o[i] = y[hb * 8 + i] * rstd * gconv[hb * 8 + i];
        *(v4u*)(ymix + (size_t)t * DM + 1024 + ch + hb * 8) = pack8(o); }
}
__device__ __forceinline__ void p2_tokens(Frame& F) {
    const bf16* proj = (const bf16*)(F.ws + WS_PROJ); bf16* ymix = (bf16*)(F.ws + WS_YMIX);
    float cw[3][16], gc[16];
#pragma unroll
    for (int q = 0; q < 4; ++q) { const f32x4 g4 = *(const f32x4*)(F.in[I_GCONV] + F.lane * 16 + 4 * q); gc[4 * q] = g4[0]; gc[4 * q + 1] = g4[1]; gc[4 * q + 2] = g4[2]; gc[4 * q + 3] = g4[3];
#pragma unroll
        for (int k = 0; k < 3; ++k) { const f32x4 w4 = *(const f32x4*)(F.in[I_CONVW] + k * 1024 + F.lane * 16 + 4 * q); cw[k][4 * q] = w4[0]; cw[k][4 * q + 1] = w4[1]; cw[k][4 * q + 2] = w4[2]; cw[k][4 * q + 3] = w4[3]; } }
    for (int t = F.gw; t < T; t += 2 * F.NGW) {
        P2Row R0, R1; const bool two = t + F.NGW < T;
        p2_load(R0, proj, t, F.lane); if (two) p2_load(R1, proj, t + F.NGW, F.lane);
        p2_finish(R0, cw, gc, ymix, t, F.lane); if (two) p2_finish(R1, cw, gc, ymix, t + F.NGW, F.lane);
    }
}

__device__ __forceinline__ void p11_router(Frame& F) {
    LAS float* rs = (LAS float*)F.lds;
    LAS float* part = rs + 64;
    LAS int* hist = (LAS int*)(part + 4 * 64 * 33);
    const bf16* x2 = (const bf16*)(F.ws + WS_HBF); const float* wrg = (const float*)(F.ws + WS_WRG); const float* ss2 = (const float*)(F.ws + WS_SS2); float* rstd2 = (float*)(F.ws + WS_RSTD2);
    int* topi = (int*)(F.ws + WS_TOPI); float* topg = (float*)(F.ws + WS_TOPG);
    const int lane = F.lane, wv = F.wave;
    for (int tile = blockIdx.x; tile < T / 64; tile += F.G) {
        const int t0 = tile * 64;
        if (F.tid < 32) hist[F.tid] = 0;
        if (wv == 1) { const f32x4* p4 = (const f32x4*)(ss2 + (size_t)(t0 + lane) * 32); f32x4 a = p4[0];
#pragma unroll
            for (int j = 1; j < 8; ++j) a += p4[j];
            const float rstd = 1.f / sqrtf(((a[0] + a[1]) + (a[2] + a[3])) * (1.f / 2048.f) + EPS); rs[lane] = rstd; rstd2[t0 + lane] = rstd; }
        { const int th = wv >> 2, kq = wv & 3, i = lane & 31, half = lane >> 5;
          f32x16 acc = {};
          const bf16* xrow = x2 + (size_t)(t0 + th * 32 + i) * DM + kq * 512 + 4 * half;
          const float* wb = wrg + (size_t)(kq * 512 + 4 * half) * 32 + i;
#define RT_LOAD(A_, B_, s0_) do { _Pragma("unroll") for (int u_ = 0; u_ < 4; ++u_) { { const v2u w_ = *(const v2u*)(xrow + 8 * ((s0_) + u_)); A_[u_] = (f32x4){lo16(w_.x), hi16(w_.x), lo16(w_.y), hi16(w_.y)}; } \
              _Pragma("unroll") for (int e_ = 0; e_ < 4; ++e_) B_[u_][e_] = wb[(8 * ((s0_) + u_) + e_) * 32]; } } while (0)
#define RT_MMA(A_, B_) do { _Pragma("unroll") for (int u_ = 0; u_ < 4; ++u_) { acc = __builtin_amdgcn_mfma_f32_32x32x2f32(A_[u_].x, B_[u_][0], acc, 0, 0, 0); acc = __builtin_amdgcn_mfma_f32_32x32x2f32(A_[u_].y, B_[u_][1], acc, 0, 0, 0); \
              acc = __builtin_amdgcn_mfma_f32_32x32x2f32(A_[u_].z, B_[u_][2], acc, 0, 0, 0); acc = __builtin_amdgcn_mfma_f32_32x32x2f32(A_[u_].w, B_[u_][3], acc, 0, 0, 0); } } while (0)
          f32x4 a0[4], a1[4]; float b0[4][4], b1[4][4];
          RT_LOAD(a0, b0, 0);
#pragma unroll 1
          for (int s8 = 0; s8 < 64; s8 += 8) { RT_LOAD(a1, b1, s8 + 4); RT_MMA(a0, b0); if (s8 + 8 < 64) RT_LOAD(a0, b0, s8 + 8); RT_MMA(a1, b1); }
#undef RT_LOAD
#undef RT_MMA
#pragma unroll
          for (int r = 0; r < 16; ++r) { const int row = (r & 3) + 8 * (r >> 2) + 4 * half; part[(kq * 64 + th * 32 + row) * 33 + i] = acc[r]; }
        }
        __syncthreads();
        if (F.tid < 64) {
            const int tk = F.tid; const float rstd = rs[tk]; float lg[32];
#pragma unroll
            for (int e = 0; e < 32; ++e) lg[e] = (part[(0 * 64 + tk) * 33 + e] + part[(1 * 64 + tk) * 33 + e] + part[(2 * 64 + tk) * 33 + e] + part[(3 * 64 + tk) * 33 + e]) * rstd + F.in[I_BROUTER][e];
            float tv[4]; int ti[4];
#pragma unroll
            for (int k = 0; k < 4; ++k) { float best = -3.0e38f; int bi = 0;
#pragma unroll
                for (int e = 0; e < 32; ++e) { const bool taken = (k > 0 && ti[0] == e) || (k > 1 && ti[1] == e) || (k > 2 && ti[2] == e); if (!taken && lg[e] > best) { best = lg[e]; bi = e; } }
                tv[k] = best; ti[k] = bi; }
            const float e1 = expf(tv[1] - tv[0]), e2 = expf(tv[2] - tv[0]), e3 = expf(tv[3] - tv[0]); const float inv = 1.f / (1.f + e1 + e2 + e3);
            const float gg[4] = {inv, e1 * inv, e2 * inv, e3 * inv};
#pragma unroll
            for (int k = 0; k < 4; ++k) { topi[(size_t)(t0 + tk) * 4 + k] = ti[k]; topg[(size_t)(t0 + tk) * 4 + k] = gg[k]; atomicAdd((int*)&hist[ti[k]], 1); }
        }
        __syncthreads();
        if (F.tid < 32) atomicAdd(F.ctl + CW_COUNTS + 64 * F.tid, (unsigned)hist[F.tid]);
        __syncthreads();
    }
}

__device__ __forceinline__ void expert_bases(Frame& F, LAS int* base, LAS int* cnt) {
    if (F.tid < 32) cnt[F.tid] = (int)__hip_atomic_load(F.ctl + CW_COUNTS + 64 * F.tid, __ATOMIC_RELAXED, __HIP_MEMORY_SCOPE_AGENT);
    __syncthreads();
    if (F.tid == 0) { int run = 0; for (int e = 0; e < 32; ++e) { base[e] = run; run += (cnt[e] + 255) & ~255; } base[32] = run; }
    __syncthreads();
}

__device__ __forceinline__ void p12_lists(Frame& F) {
    LAS int* base = (LAS int*)F.lds; LAS int* cnt = base + 40; LAS int* hist = cnt + 32; LAS int* wgb = hist + 32;
    const int* topi = (const int*)(F.ws + WS_TOPI); int* pos = (int*)(F.ws + WS_POS); int* list = (int*)(F.ws + WS_LIST); const float* rstd2 = (const float*)(F.ws + WS_RSTD2); float* rss = (float*)(F.ws + WS_RSS);
    expert_bases(F, base, cnt);
    for (int tile = blockIdx.x; tile < T / 64; tile += F.G) {
        if (F.tid < 32) hist[F.tid] = 0;
        __syncthreads();
        int e = 0, r = 0;
        if (F.tid < 256) { e = topi[(size_t)tile * 256 + F.tid]; r = atomicAdd((int*)&hist[e], 1); }
        __syncthreads();
        if (F.tid < 32) wgb[F.tid] = (int)atomicAdd(F.ctl + CW_CURSOR + 64 * F.tid, (unsigned)hist[F.tid]);
        __syncthreads();
        if (F.tid < 256) { const int p = base[e] + wgb[e] + r; pos[(size_t)tile * 256 + F.tid] = p; list[p] = tile * 64 + (F.tid >> 2); rss[p] = rstd2[tile * 64 + (F.tid >> 2)]; }
        __syncthreads();
    }
    if (blockIdx.x == 0 && F.tid < 32) { for (int p = base[F.tid] + cnt[F.tid]; p < base[F.tid + 1]; ++p) { list[p] = 0; rss[p] = 1.f; } }
}

__device__ __forceinline__ void p15_combine(Frame& F) {
    const int* pos = (const int*)(F.ws + WS_POS); const float* topg = (const float*)(F.ws + WS_TOPG); const unsigned char* Y = F.ws + WS_Y; const bf16* X2 = (const bf16*)(F.ws + WS_HBF); const int lane = F.lane;
    int t = F.gw; if (t >= T) return;
    int pk[4]; float gk[4];
#pragma unroll
    for (int k = 0; k < 4; ++k) { pk[k] = pos[(size_t)t * 4 + k]; gk[k] = topg[(size_t)t * 4 + k]; }
    for (;;) {
        const int tn = t + F.NGW; const bool more = tn < T; const int tq = more ? tn : t;
        int pn[4]; float gn[4];
#pragma unroll
        for (int k = 0; k < 4; ++k) { pn[k] = pos[(size_t)tq * 4 + k]; gn[k] = topg[(size_t)tq * 4 + k]; }
        float* orow = F.out + (size_t)t * DM;
        v4u xw[4]; v2u yw[4][4];
#pragma unroll
        for (int j = 0; j < 4; ++j) { const int c = (lane + 64 * j) * 8; xw[j] = __builtin_nontemporal_load((const v4u*)(X2 + (size_t)t * DM + c));
#pragma unroll
            for (int k = 0; k < 4; ++k) yw[j][k] = __builtin_nontemporal_load((const v2u*)(Y + (size_t)pk[k] * DM + c)); }
#pragma unroll
        for (int j = 0; j < 4; ++j) { const int c = (lane + 64 * j) * 8; float xf[8]; unpack8(xw[j], xf); f32x4 a = {xf[0], xf[1], xf[2], xf[3]}, b = {xf[4], xf[5], xf[6], xf[7]};
#pragma unroll
            for (int k = 0; k < 4; ++k) { const float g = gk[k] * pg8::Y8_INV; const auto f01 = __builtin_amdgcn_cvt_pk_f32_fp8((int)yw[j][k].x, false), f23 = __builtin_amdgcn_cvt_pk_f32_fp8((int)yw[j][k].x, true), f45 = __builtin_amdgcn_cvt_pk_f32_fp8((int)yw[j][k].y, false), f67 = __builtin_amdgcn_cvt_pk_f32_fp8((int)yw[j][k].y, true);
                a.x += g * f01[0]; a.y += g * f01[1]; a.z += g * f23[0]; a.w += g * f23[1]; b.x += g * f45[0]; b.y += g * f45[1]; b.z += g * f67[0]; b.w += g * f67[1]; }
            __builtin_nontemporal_store(a, (f32x4*)(orow + c)); __builtin_nontemporal_store(b, (f32x4*)(orow + c + 4)); }
        if (!more) break;
        t = tn;
#pragma unroll
        for (int k = 0; k < 4; ++k) { pk[k] = pn[k]; gk[k] = gn[k]; }
    }
}

__global__ void __launch_bounds__(NTHREADS, 2) fwd(Args args) {
    extern __shared__ __attribute__((aligned(16))) unsigned char lds[];
    Frame F;
    F.lds = (LAS unsigned char*)lds; F.tid = threadIdx.x; F.lane = F.tid & 63; F.wave = __builtin_amdgcn_readfirstlane(F.tid >> 6);
    F.G = gridDim.x; { const int bx = blockIdx.x; F.vcu = (F.G % 8 == 0) ? (bx % 8) * (F.G / 8) + bx / 8 : bx; }
    F.gw = F.vcu * NWAVES + F.wave; F.NGW = F.G * NWAVES;
    F.in = args.in; F.out = args.out; F.ws = args.ws; F.ctl = (unsigned*)(args.ws + WS_CTL);
    const int lo = args.ph_lo, hi = args.ph_hi;
    volatile LAS unsigned* MISC = (volatile LAS unsigned*)(F.lds + MISC_OFF);
    if (F.tid < 32) MISC[F.tid] = 0u;
    __syncthreads();
#define SEAM(k) do { if (IN(k) && IN((k) + 1)) { xcd_barrier_nb((unsigned*)(args.ws + WS_CTL) + CW_BAR, xb_xcc_id(), (volatile LAS unsigned*)((LAS unsigned char*)lds + MISC_OFF) + 8); } } while (0)
#ifndef ONLY
#define ONLY -1
#endif
#define IN(k) ((ONLY < 0 || ONLY == (k)) && lo <= (k) && (k) < hi)
    unsigned char* ws = args.ws;
    bf16* hbf = (bf16*)(ws + WS_HBF); bf16* proj = (bf16*)(ws + WS_PROJ); bf16* ymix = (bf16*)(ws + WS_YMIX);

    if (IN(0)) { p0_prologue(F); }
    if (hi - lo > 1) (void)xcd_barrier_post((unsigned*)(args.ws + WS_CTL) + CW_BAR, (volatile LAS unsigned*)((LAS unsigned char*)lds + MISC_OFF) + 8);
    SEAM(0);
    if (IN(1)) { pg8::DenseOrder S; S.init(hbf, ws + WS_WMIXIN, T, NPROJ, DM, F.G, (int)blockIdx.x);
                 const bool conv_first = (F.vcu & 1) == 0;
                 if (conv_first) late_work(F);
                 pg8::gemm_phase<pg8::EpiProj, pg8::DenseOrder, false, true>(F.lds, DM, S, pg8::EpiProj{proj, F.in[I_GQ], F.in[I_GK], (LAS float*)(F.lds + RSS_OFF)});
                 if (!conv_first) late_work(F); }
    SEAM(1);
    if (IN(3)) {
        const bool p2_first = (F.vcu & 1) == 0;
        if (p2_first) p2_tokens(F);
        const float* biasS = (const float*)(ws + WS_BIAS); char* L = (char*)lds; float* ssf = (float*)(ws + WS_SSF);
        constexpr int W = 1 << 20; const int total = BATCH * FH * 4;
        int cur_bh = -1; bool primed = false; fa::Seam S;
        auto ref = [&](int item, int pass) { const int bh = item >> 2, x = item & 3, qb = pass ? 7 - x : x, b = bh >> 3, h = bh & 7; const size_t t0 = (size_t)b * SEQ + qb * 256;
            fa::BlockRef r; r.Q = proj + t0 * NPROJ + 3072 + h * HD; r.K = proj + (size_t)b * SEQ * NPROJ + 4096 + h * HD; r.V = r.K + 1024; r.O = ymix + t0 * DM + h * HD; r.P0 = qb * 256; return r; };
        for (int item = blockIdx.x; item < total; item += F.G) {
            const int bh = item >> 2;
            if (bh != cur_bh) { __syncthreads(); *(f32x4*)(L + fa::BIAS_OFF + F.tid * 16) = *(const f32x4*)(biasS + (size_t)bh * SEQ + F.tid * 4); cur_bh = bh; __syncthreads(); }
            fa::BlockRef c0 = ref(item, 0), c1 = ref(item, 1);
            if (!primed) { fa::prime<NPROJ, NPROJ>(c0, W, L, S); primed = true; }
            const bool more = item + F.G < total; fa::BlockRef nx = more ? ref(item + F.G, 0) : c1;
            fa::block<NPROJ, NPROJ, DM, true, true, true>(c0, c1, SEQ, W, L, S, ymix, ssf);
            fa::block<NPROJ, NPROJ, DM, true, true, true>(c1, nx, SEQ, W, L, S, ymix, ssf);
        }
        asm volatile("s_waitcnt vmcnt(0)" ::: "memory"); __syncthreads();
        if (!p2_first) p2_tokens(F);
    }
    SEAM(3);
    if (IN(4)) { pg8::DenseOrder S; S.init(ymix, ws + WS_WMIXOUT, T, DM, DM, F.G, (int)blockIdx.x);
                 LAS float* rl = (LAS float*)(F.lds + RSS_OFF); const float* ssf = (const float*)(ws + WS_SSF);
                 { pg8::Unit u; for (int i = 0; i < RSS_UNITS && S.next(i, u); ++i) if (F.tid < 256) { const f32x4 s0 = *(const f32x4*)(ssf + (size_t)(u.pm * 256 + F.tid) * 8), s1 = *(const f32x4*)(ssf + (size_t)(u.pm * 256 + F.tid) * 8 + 4);
                       rl[i * 256 + F.tid] = 1.f / sqrtf(((s0[0] + s0[1]) + (s0[2] + s0[3]) + (s1[0] + s1[1]) + (s1[2] + s1[3])) * (1.f / 1024.f) + EPS); } }
                 __syncthreads();
                 pg8::gemm_phase<pg8::EpiRes1, pg8::DenseOrder, false, true, true>(F.lds, DM, S, pg8::EpiRes1{(const float*)(ws + WS_RSTD2), F.in[I_GMIX], hbf, (float*)(ws + WS_SS1), ssf, rl}); }
    SEAM(4);
    if (IN(5)) { pg8::DualOrder S{128, 2, 32, 4, 64, F.G, (int)blockIdx.x, (const char*)hbf, (const char*)(ws + WS_WXQ), (const char*)(ws + WS_MEMN), (const char*)(ws + WS_WXKV), (size_t)256 * DM * 2};
                 pg8::gemm_phase<pg8::EpiXProj, pg8::DualOrder, false, true>(F.lds, DM, S, pg8::EpiXProj{(bf16*)(ws + WS_QX), (bf16*)(ws + WS_KVX), F.in[I_GXQ], F.in[I_GXK], (const float*)(ws + WS_SS1), (LAS float*)(F.lds + RSS_OFF)}); }
    SEAM(5);
    if (IN(7)) {
        const bf16* qx = (const bf16*)(ws + WS_QX); const bf16* kvx = (const bf16*)(ws + WS_KVX); bf16* ox = (bf16*)(ws + WS_OX); char* L = (char*)lds;
        constexpr int W = 1 << 20; const int total = BATCH * XH * 8;
        bool primed = false; fa::Seam S;
        auto ref = [&](int item) { const int qb = item & 7, h = (item >> 3) & 3, b = item >> 5; const size_t t0 = (size_t)b * SEQ + qb * 256;
            fa::BlockRef r; r.Q = qx + t0 * XW + h * HD; r.K = kvx + (size_t)b * MEMT * 1024 + h * HD; r.V = r.K + 512; r.O = ox + t0 * XW + h * HD; r.P0 = 256; return r; };
        for (int item = blockIdx.x; item < total; item += F.G) {
            fa::BlockRef c0 = ref(item);
            if (!primed) { fa::prime<XW, 1024>(c0, W, L, S); primed = true; }
            const bool more = item + F.G < total; fa::BlockRef nx = more ? ref(item + F.G) : c0;
            fa::block<XW, 1024, XW, false, false, false>(c0, nx, MEMT, W, L, S);
        }
        asm volatile("s_waitcnt vmcnt(0)" ::: "memory"); __syncthreads();
    }
    SEAM(7);
    if (IN(8)) { pg8::DenseOrder S; S.init(ws + WS_OX, ws + WS_WXO, T, DM, XW, F.G, (int)blockIdx.x);
                 pg8::gemm_phase<pg8::EpiRes2, pg8::DenseOrder, false, true>(F.lds, XW, S, pg8::EpiRes2{hbf, (float*)(ws + WS_SS2), ws + WS_X2N8, F.in[I_GMOE]}); }
    SEAM(8);
    if (IN(9)) { p11_router(F); }
    SEAM(9);
    if (IN(10)) { p12_lists(F); }
    SEAM(10);
    if (IN(11) || IN(12)) {
        LAS int* base = (LAS int*)(F.lds + TABLE_OFF); LAS int* cnt = base + 40; LAS short* tile_e = (LAS short*)(cnt + 32);
        expert_bases(F, base, cnt);
        const int ntile = base[32] / 256; const int* list = (const int*)(ws + WS_LIST);
        for (int pm = F.tid; pm < ntile; pm += NTHREADS) { int e = 0; while (base[e + 1] <= pm * 256) ++e; tile_e[pm] = (short)e; }
        __syncthreads();
        if (IN(11)) { pg8::MoeOrder S{ntile * 16, 16, F.G, F.vcu, (const char*)(ws + WS_X2N8), (const char*)(ws + WS_WGU), (size_t)4096 * DM, (size_t)256 * DM, tile_e, list, true};
            LAS float* rl = (LAS float*)(F.lds + RSS_OFF);
            { pg8::Unit u; for (int i = 0; i < RSS_UNITS && S.next(i, u); ++i) if (F.tid < 256) rl[i * 256 + F.tid] = ((const float*)(ws + WS_RSS))[u.pm * 256 + F.tid]; }
            __syncthreads();
            pg8::gemm_phase8<pg8::EpiGlu8, pg8::MoeOrder, true, true>(F.lds, DM, S, pg8::EpiGlu8{(unsigned char*)(ws + WS_GLU), F.in[I_BGU], tile_e, (const float*)(ws + WS_RSS), rl}); }
        SEAM(11);
        if (IN(12)) { pg8::MoeOrder S{ntile * 8, 8, F.G, F.vcu, (const char*)(ws + WS_GLU), (const char*)(ws + WS_WDN), (size_t)DM * DFF, (size_t)256 * DFF, tile_e, list, false};
            pg8::gemm_phase8<pg8::EpiBiasFp8, pg8::MoeOrder, false, true>(F.lds, DFF, S, pg8::EpiBiasFp8{ws + WS_Y, F.in[I_BDN], tile_e}); }
    }
    SEAM(12);
    if (IN(13)) { p15_combine(F); }
#undef IN
}

extern "C" void kernel_launch(void* const* d_in, const int* in_sizes, int n_in, void* d_out, int out_size, void* d_ws, size_t ws_size, hipStream_t stream) {
    static int grid = 0;
    if (grid == 0) {
        if (n_in != 25 || out_size != T * DM || ws_size < WS_END) { fprintf(stderr, "kernel_launch: unexpected shapes (n_in %d out %d ws %zu need %zu)\n", n_in, out_size, ws_size, (size_t)WS_END); grid = -1; return; }
        int dev = 0, cus = 0;
        if (hipGetDevice(&dev) != hipSuccess || hipDeviceGetAttribute(&cus, hipDeviceAttributeMultiprocessorCount, dev) != hipSuccess) { grid = -1; return; }
        if (hipFuncSetAttribute((const void*)fwd, hipFuncAttributeMaxDynamicSharedMemorySize, LDS_BYTES) != hipSuccess) { fprintf(stderr, "kernel_launch: hipFuncSetAttribute failed\n"); grid = -1; return; }
        if (cus < 192) { fprintf(stderr, "kernel_launch: %d CUs: the per-workgroup LDS caches assume at least 192\n", cus); grid = -1; return; }
        grid = cus;
    }
    if (grid < 0) return;
    (void)hipMemsetAsync((char*)d_ws + WS_CTL, 0, CTL_ZERO_BYTES, stream);
    Args a{};
    for (int i = 0; i < 25; ++i) a.in[i] = (const float*)d_in[i];
    a.out = (float*)d_out; a.ws = (unsigned char*)d_ws;
#if ONE_LAUNCH
    a.ph_lo = 0; a.ph_hi = NPH; hipLaunchKernelGGL(fwd, dim3(grid), dim3(NTHREADS), LDS_BYTES, stream, a);
#ifdef EXTRA_PHASES
    { const int extra[] = {EXTRA_PHASES}; a.out = (float*)((unsigned char*)d_ws + WS_END);     for (int ph : extra) { a.ph_lo = ph; a.ph_hi = ph + 1; hipLaunchKernelGGL(fwd, dim3(grid), dim3(NTHREADS), LDS_BYTES, stream, a); } }
#endif
#else
    for (int ph = 0; ph < NPH; ++ph) { a.ph_lo = ph; a.ph_hi = ph + 1; hipLaunchKernelGGL(fwd, dim3(grid), dim3(NTHREADS), LDS_BYTES, stream, a); }
#endif
}
```

```cpp
#include <hip/hip_runtime.h>
#include <cstdio>
#include <cstdint>

constexpr int BATCH = 8, SEQ = 2048, DM = 2048, T = BATCH * SEQ;
constexpr int CONVW = 1024, FOXW = 1024, HD = 128, FH = 8, NPROJ = 6144, MIXIN = 6152;
constexpr int MEMT = 256, XH = 4, XW = 512, NE = 32, TOPK = 4, DFF = 2048;
constexpr int MROWS = BATCH * MEMT;
constexpr float EPS = 1e-6f, SW_LIMIT = 7.0f, SW_ALPHA = 1.702f;
constexpr float ATT_SCALE = 0.08838834764831845f;
constexpr int MAXROWS = T * TOPK + NE * 256;
constexpr int NWAVES = 8, NTHREADS = 512;

constexpr size_t MiB = 1u << 20;
constexpr size_t WS_CTL = 0, CTL_ZERO_BYTES = 65536;
constexpr size_t WS_WMIXIN = 1 * MiB;
constexpr size_t WS_WMIXOUT = WS_WMIXIN + 24 * MiB;
constexpr size_t WS_WXQ = WS_WMIXOUT + 8 * MiB;
constexpr size_t WS_WXKV = WS_WXQ + 2 * MiB;
constexpr size_t WS_WXO = WS_WXKV + 4 * MiB;
constexpr size_t WS_WRG = WS_WXO + 2 * MiB;
constexpr size_t WS_WGU = WS_WRG + 1 * MiB;
constexpr size_t WS_WDN = WS_WGU + 512 * MiB;
constexpr size_t WS_HBF = WS_WDN + 256 * MiB;
constexpr size_t WS_PROJ = WS_HBF + 64 * MiB;
constexpr size_t WS_YMIX = WS_PROJ + 192 * MiB;
constexpr size_t WS_MEMN = WS_YMIX + 64 * MiB;
constexpr size_t WS_KVX = WS_MEMN + 8 * MiB;
constexpr size_t WS_QX = WS_KVX + 4 * MiB;
constexpr size_t WS_OX = WS_QX + 16 * MiB;
constexpr size_t WS_LOGF = WS_OX + 16 * MiB;
constexpr size_t WS_BIAS = WS_LOGF + 1 * MiB;
constexpr size_t WS_TOPI = WS_BIAS + 1 * MiB;
constexpr size_t WS_TOPG = WS_TOPI + 1 * MiB;
constexpr size_t WS_POS = WS_TOPG + 1 * MiB;
constexpr size_t WS_LIST = WS_POS + 1 * MiB;
constexpr size_t WS_GLU = WS_LIST + 1 * MiB;
constexpr size_t WS_Y = WS_GLU + 288 * MiB;
constexpr size_t WS_X2N8 = WS_Y + 288 * MiB;
constexpr size_t WS_SSF = WS_X2N8 + 32 * MiB;
constexpr size_t WS_SS1 = WS_SSF + 1 * MiB;
constexpr size_t WS_SS2 = WS_SS1 + 2 * MiB;
constexpr size_t WS_RSTD2 = WS_SS2 + 2 * MiB;
constexpr size_t WS_RSS = WS_RSTD2 + 1 * MiB;
constexpr size_t WS_END = WS_RSS + 1 * MiB;

constexpr int CW_COUNTS = 8192;
constexpr int CW_CURSOR = 12288;
constexpr int CW_BAR = 4096;

constexpr int LDS_BYTES = 163840;
constexpr int RSS_OFF = 134144, RSS_UNITS = 24;
constexpr int TABLE_OFF = 131072;
constexpr int MISC_OFF = 163328;
#ifndef ONE_LAUNCH
#define ONE_LAUNCH 1
#endif

#define GAS __attribute__((address_space(1)))
#define LAS __attribute__((address_space(3)))
typedef unsigned short bf16;
typedef unsigned v4u __attribute__((ext_vector_type(4)));
typedef unsigned v2u __attribute__((ext_vector_type(2)));
typedef float f32x4 __attribute__((ext_vector_type(4)));
typedef float f32x16 __attribute__((ext_vector_type(16)));
typedef short bf16x8 __attribute__((ext_vector_type(8)));
typedef int v8i __attribute__((ext_vector_type(8)));
typedef short s16x16 __attribute__((ext_vector_type(16)));

__device__ __forceinline__ float bf2f(unsigned u16) { return __builtin_bit_cast(float, u16 << 16); }
__device__ __forceinline__ unsigned f2bf(float f) { unsigned u = __builtin_bit_cast(unsigned, f); return (u + 0x7fffu + ((u >> 16) & 1u)) >> 16; }
__device__ __forceinline__ unsigned pk2(float lo, float hi) { return f2bf(lo) | (f2bf(hi) << 16); }
__device__ __forceinline__ float lo16(unsigned w) { return __builtin_bit_cast(float, w << 16); }
__device__ __forceinline__ float hi16(unsigned w) { return __builtin_bit_cast(float, w & 0xffff0000u); }
__device__ __forceinline__ float wave_sum(float v) {
#pragma unroll
    for (int o = 1; o < 64; o <<= 1) v += __shfl_xor(v, o);
    return v;
}
__device__ __forceinline__ void unpack8(v4u w, float* f) {
    f[0] = lo16(w.x); f[1] = hi16(w.x); f[2] = lo16(w.y); f[3] = hi16(w.y); f[4] = lo16(w.z); f[5] = hi16(w.z); f[6] = lo16(w.w); f[7] = hi16(w.w);
}
__device__ __forceinline__ v4u pack8(const float* f) { v4u w; w.x = pk2(f[0], f[1]); w.y = pk2(f[2], f[3]); w.z = pk2(f[4], f[5]); w.w = pk2(f[6], f[7]); return w; }


#define XB_TMO      128
#define XB_XCNT(j)  (256  + 64 * (j))
#define XB_XSUB(j)  (1280 + 64 * (j))
#define XB_XGEN(j)  (2304 + 64 * (j))
#define XB_TOP      3328
#define XB_TOPGEN   3392
#define XCD_BAR_WORDS 3456
#define XB_SPIN_CAP (1u << 18)
__device__ __forceinline__ unsigned xb_ld(unsigned* p)              { return __hip_atomic_load(p, __ATOMIC_RELAXED, __HIP_MEMORY_SCOPE_AGENT); }
__device__ __forceinline__ unsigned xb_add(unsigned* p, unsigned v) { return __hip_atomic_fetch_add(p, v, __ATOMIC_RELAXED, __HIP_MEMORY_SCOPE_AGENT); }
__device__ __forceinline__ unsigned xb_xcc_id() { return (unsigned)__builtin_amdgcn_s_getreg((3 << 11) | 20) & 0xFu; }
#define XB_SPIN(cond, bar) do { unsigned _sp = 0; while (cond) { __builtin_amdgcn_s_sleep(1); \
    if ((++_sp & 255u) == 0u) { if (xb_ld(&(bar)[XB_TMO])) break; if (_sp > XB_SPIN_CAP) { atomicAdd(&(bar)[XB_TMO], 1u); break; } } } } while (0)
struct XcdBarrier { unsigned* bar; unsigned x; volatile LAS unsigned* st; };
__device__ __forceinline__ XcdBarrier xcd_barrier_post(unsigned* bar, volatile LAS unsigned* st) {
    XcdBarrier b; b.bar = bar; b.x = xb_xcc_id(); b.st = st;
    if (threadIdx.x == 0) (void)xb_add(&bar[XB_XCNT(b.x)], 1u);
    return b;
}
__device__ __forceinline__ void xcd_barrier_complete(unsigned* bar, unsigned x, unsigned& nloc, unsigned& nx) {
    const unsigned G = gridDim.x * gridDim.y * gridDim.z;
    unsigned sum, cnt, mine, sp = 0u;
    for (;;) {
        sum = 0u; cnt = 0u; mine = 0u;
#pragma unroll
        for (unsigned j = 0; j < 16; ++j) { const unsigned c = xb_ld(&bar[XB_XCNT(j)]); sum += c; cnt += (c > 0u) ? 1u : 0u; mine = (j == x) ? c : mine; }
        if (sum == G) break;
        __builtin_amdgcn_s_sleep(1);
        if ((++sp & 255u) == 0u) { if (xb_ld(&bar[XB_TMO])) break; if (sp > XB_SPIN_CAP) { atomicAdd(&bar[XB_TMO], 1u); break; } }
    }
    nloc = mine > 0u ? mine : 1u; nx = cnt > 0u ? cnt : 1u;
}
__device__ __noinline__ void xcd_barrier_nb(unsigned* bar_, unsigned x_, volatile LAS unsigned* st_) {
    XcdBarrier b; b.bar = bar_; b.x = x_; b.st = st_;
    asm volatile("s_waitcnt vmcnt(0)" ::: "memory");
    __syncthreads();
    if (threadIdx.x == 0) {
        unsigned* bar = b.bar;
        __builtin_amdgcn_s_waitcnt(0);
        unsigned nloc = b.st[0], nx = b.st[1];
        if (nloc == 0u) { xcd_barrier_complete(bar, b.x, nloc, nx); b.st[0] = nloc; b.st[1] = nx; }
        const unsigned old = xb_add(&bar[XB_XSUB(b.x)], 1u);
        const unsigned gen = old / nloc;
        if (old + 1u == (gen + 1u) * nloc) {
            __builtin_amdgcn_fence(__ATOMIC_RELEASE, "agent");
            asm volatile("s_waitcnt vmcnt(0)" ::: "memory");
            const unsigned og = xb_add(&bar[XB_TOP], 1u);
            const unsigned tg = og / nx;
            if (og + 1u == (tg + 1u) * nx) xb_add(&bar[XB_TOPGEN], 1u);
            else XB_SPIN(xb_ld(&bar[XB_TOPGEN]) == tg, bar);
            __builtin_amdgcn_fence(__ATOMIC_ACQUIRE, "agent");
            xb_add(&bar[XB_XGEN(b.x)], 1u);
            asm volatile("s_waitcnt vmcnt(0)" ::: "memory");
        } else {
            XB_SPIN(xb_ld(&bar[XB_XGEN(b.x)]) == gen, bar);
            __builtin_amdgcn_fence(__ATOMIC_ACQUIRE, "agent");
            asm volatile("s_waitcnt vmcnt(0)" ::: "memory");
        }
    }
    __syncthreads();
}

struct Args { const float* in[25]; float* out; unsigned char* ws; int ph_lo, ph_hi; };
enum { I_X = 0, I_MEM, I_GMIX, I_WMIXIN, I_BFORGET, I_CONVW, I_GQ, I_GK, I_GCONV, I_GFOX, I_WMIXOUT, I_GXATTN, I_GMEM, I_WXQ, I_WXKV, I_GXQ, I_GXK, I_WXO,
       I_GMOE, I_WROUTER, I_BROUTER, I_WGU, I_BGU, I_WDN, I_BDN };

struct Frame {
    LAS unsigned char* lds;
    unsigned* ctl;
    int tid, lane, wave, vcu, G, gw, NGW;
    const float* const* in; float* out; unsigned char* ws;
};

__device__ __forceinline__ void transpose_item(const float* W, int ldw, int K, int k0, int n0, bf16* WT, int drow0, LAS float* scr, int lane, int kd0, const float* gk) {
    float r_[32];
#pragma unroll
    for (int i = 0; i < 32; ++i) { const int kk = 2 * i + (lane >> 5); r_[i] = W[(size_t)(k0 + kk) * ldw + n0 + (lane & 31)]; }
    if (gk) {
#pragma unroll
        for (int i = 0; i < 32; ++i) r_[i] *= gk[2 * i + (lane >> 5)]; }
#pragma unroll
    for (int i = 0; i < 32; ++i) { const int kk = 2 * i + (lane >> 5); scr[kk * 33 + (lane & 31)] = r_[i]; }
    asm volatile("s_waitcnt lgkmcnt(0)" ::: "memory");
    const int c = lane & 7;
#pragma unroll
    for (int j = 0; j < 4; ++j) { const int n = (lane >> 3) + 8 * j; const LAS float* s = scr + (8 * c) * 33 + n;
        v4u o; o.x = pk2(s[0 * 33], s[1 * 33]); o.y = pk2(s[2 * 33], s[3 * 33]); o.z = pk2(s[4 * 33], s[5 * 33]); o.w = pk2(s[6 * 33], s[7 * 33]);
        *(v4u*)(WT + (size_t)(drow0 + n) * K + kd0 + 8 * c) = o; }
    asm volatile("s_waitcnt lgkmcnt(0)" ::: "memory");
}


__device__ __forceinline__ void rms_row_2048(const float* xrow, const float* gain, bf16* orow, int lane, f32x4 (&v)[8]) {
    const f32x4* xr = (const f32x4*)xrow + lane; const f32x4* gr = (const f32x4*)gain + lane;
    float s = 0.f;
#pragma unroll
    for (int j = 0; j < 8; ++j) { v[j] = xr[64 * j]; s += (v[j].x * v[j].x + v[j].y * v[j].y) + (v[j].z * v[j].z + v[j].w * v[j].w); }
    const float rstd = 1.f / sqrtf(wave_sum(s) * (1.f / 2048.f) + EPS);
    v2u* o8 = (v2u*)orow + lane;
#pragma unroll
    for (int j = 0; j < 8; ++j) { const f32x4 g = gr[64 * j]; v[j] = v[j] * rstd * g; v2u w; w.x = pk2(v[j].x, v[j].y); w.y = pk2(v[j].z, v[j].w); o8[64 * j] = w; }
}

__device__ __forceinline__ float log_sigmoid(float z) { return fminf(z, 0.f) - log1pf(expf(-fabsf(z))); }

namespace pg8 {
constexpr int BM = 256, BK = 64, HALF = 128, HTB = HALF * BK * 2, NXCD = 8, WGM = 8;
__host__ __device__ __forceinline__ int lds_byte(int r, int c) { const int st = (r >> 4) * 2 + (c >> 5), rr = r & 15, cc = c & 31, ob = rr * 64 + cc * 2; return st * 1024 + (ob ^ (((ob >> 9) & 1) << 5)); }
__host__ __device__ __forceinline__ void stage_rc(int b, int& R, int& C) { const int st = b / 1024, sb = b % 1024, swz = sb ^ (((sb >> 9) & 1) << 5); R = (st >> 1) * 16 + swz / 64; C = (st & 1) * 32 + (swz % 64) / 2; }
__host__ __device__ __forceinline__ int perm32(int rho) { const int n = rho >> 4, i = rho & 15; return 8 * (i >> 2) + 4 * n + (i & 3); }
struct Unit { int pm, pn; const char* A; const char* B; };
__device__ __forceinline__ unsigned cvt_pk_bf16(float lo, float hi) { unsigned r; asm volatile("v_cvt_pk_bf16_f32 %0, %1, %2" : "=v"(r) : "v"(lo), "v"(hi)); return r; }
__device__ __forceinline__ unsigned pk4_fp8(float a, float b, float c, float d) { int w = 0; w = __builtin_amdgcn_cvt_pk_fp8_f32(a, b, w, false); w = __builtin_amdgcn_cvt_pk_fp8_f32(c, d, w, true); return (unsigned)w; }

struct DenseOrder {
    int nM, nN, nwg, G, c; const char* A; const char* B; size_t tstep;
    __device__ __forceinline__ void init(const void* A_, const void* B_, int M, int N, int K, int G_, int c_) { nM = M / BM; nN = N / BM; nwg = nM * nN; G = G_; c = c_; A = (const char*)A_; B = (const char*)B_; tstep = (size_t)BM * K * 2; }
    __device__ __forceinline__ bool next(int i, Unit& u) const {
        const long L = (long)i * G + c; if (L >= nwg) return false;
        int wgid = (int)L; { const int q = nwg / NXCD, r = nwg % NXCD, xcd = wgid % NXCD, off = wgid / NXCD; wgid = (xcd < r ? xcd * (q + 1) : r * (q + 1) + (xcd - r) * q) + off; }
        const int nig = WGM * nN, gid = wgid / nig, fm = gid * WGM, gsz = (nM - fm) < WGM ? (nM - fm) : WGM;
        u.pm = fm + ((wgid % nig) % gsz); u.pn = (wgid % nig) / gsz; u.A = A + (size_t)u.pm * tstep; u.B = B + (size_t)u.pn * tstep; return true;
    }
    __device__ __forceinline__ int row(int) const { return 0; }
};

template <class Epi, class Sched, bool GATHER, bool ALIGN_EPI, bool MID = false>
__device__ __forceinline__ void gemm_phase(LAS unsigned char* lds, const int K, const Sched& S, const Epi& E) {
    const int tid = threadIdx.x, wid = __builtin_amdgcn_readfirstlane(tid >> 6), lane = tid & 63, wr = wid >> 2, wc = wid & 3, fr = lane & 15, fq = lane >> 4;
    const int nt = K / BK;
    unsigned voffB[2]; int RA[2], CA[2];
#pragma unroll
    for (int i = 0; i < 2; ++i) { int R, C; stage_rc(tid * 16 + i * 8192, R, C); const int Rb = (R & ~31) + perm32(R & 31); RA[i] = R; CA[i] = C; voffB[i] = (unsigned)(Rb * K + C) * 2u; }
    const size_t kstep = (size_t)(BK * 2);
    const size_t hstep = (size_t)HALF * K * 2;
    const unsigned ldsw = (unsigned)wid * 1024u;
    const int aoff = lds_byte(wr * 64 + fr, fq * 8), boff = lds_byte(wc * 32 + fr, fq * 8);
#define PG8_SA(b, h) (((b) * 2 + (h)) * HTB)
#define PG8_SB(b, h) ((4 + (b) * 2 + (h)) * HTB)
#define PG8_STAGEB(bufoff, gbase) do { _Pragma("unroll") for (int _i = 0; _i < 2; ++_i) \
        __builtin_amdgcn_global_load_lds((const unsigned*)((const char*)(gbase) + voffB[_i]), (LAS unsigned*)(lds + (bufoff) + ldsw + _i * 8192), 16, 0, 0); } while (0)
#define PG8_STAGEA(bufoff, gbase, vo, h) do { _Pragma("unroll") for (int _i = 0; _i < 2; ++_i) \
        __builtin_amdgcn_global_load_lds((const unsigned*)((const char*)(gbase) + (vo)[h][_i]), (LAS unsigned*)(lds + (bufoff) + ldsw + _i * 8192), 16, 0, 0); } while (0)
#define PG8_LDA(dst, b, h) do { _Pragma("unroll") for (int m = 0; m < 4; ++m) _Pragma("unroll") for (int k = 0; k < 2; ++k) dst[m][k] = *(const LAS bf16x8*)(lds + PG8_SA(b, h) + aoff + m * 2048 + k * 1024); } while (0)
#define PG8_LDB(dst, b, h) do { _Pragma("unroll") for (int n = 0; n < 2; ++n) _Pragma("unroll") for (int k = 0; k < 2; ++k) dst[n][k] = *(const LAS bf16x8*)(lds + PG8_SB(b, h) + boff + n * 2048 + k * 1024); } while (0)
#define PG8_MMA(ai, bj, At, Bt) do { __builtin_amdgcn_s_setprio(1); _Pragma("unroll") for (int m = 0; m < 4; ++m) _Pragma("unroll") for (int n = 0; n < 2; ++n) _Pragma("unroll") for (int k = 0; k < 2; ++k) \
        acc[ai][bj][m][n] = __builtin_amdgcn_mfma_f32_16x16x32_bf16(Bt[n][k], At[m][k], acc[ai][bj][m][n], 0, 0, 0); __builtin_amdgcn_s_setprio(0); } while (0)
#define PG8_WAIT_V(n) asm volatile("s_waitcnt vmcnt(" #n ")" ::: "memory")
#define PG8_WAIT_L(n) asm volatile("s_waitcnt lgkmcnt(" #n ")" ::: "memory")
#define PG8_BAR __builtin_amdgcn_s_barrier()
#define PG8_SCHED __builtin_amdgcn_sched_barrier(0)
#define PG8_SETA(vo, u) do { _Pragma("unroll") for (int _h = 0; _h < 2; ++_h) _Pragma("unroll") for (int _i = 0; _i < 2; ++_i) { \
        if constexpr (GATHER) (vo)[_h][_i] = (unsigned)S.row((u).pm * BM + _h * HALF + RA[_i]) * (unsigned)(K * 2) + (unsigned)(CA[_i] * 2); \
        else (vo)[_h][_i] = (unsigned)((_h * HALF + RA[_i]) * K + CA[_i]) * 2u; } } while (0)
    Unit cur, nxt; int ui = 0;
    if (!S.next(0, cur)) return;
    f32x4 acc[2][2][4][2];
#pragma unroll
    for (int a = 0; a < 2; ++a)
#pragma unroll
        for (int b = 0; b < 2; ++b)
#pragma unroll
            for (int m = 0; m < 4; ++m)
#pragma unroll
                for (int n = 0; n < 2; ++n) acc[a][b][m][n] = (f32x4){0.f, 0.f, 0.f, 0.f};
    bf16x8 At[4][2], B0[2][2], B1[2][2];
    unsigned vC[2][2], vN[2][2];
    PG8_SETA(vC, cur);
    const char* cA = cur.A; const char* cB = cur.B;
    PG8_STAGEB(PG8_SB(0, 0), cB); PG8_STAGEB(PG8_SB(0, 1), cB + hstep); PG8_STAGEA(PG8_SA(0, 0), cA, vC, 0); PG8_STAGEA(PG8_SA(0, 1), cA, vC, 1);
    if (wr == 1) PG8_BAR;
    PG8_WAIT_V(2); PG8_BAR;
    PG8_STAGEB(PG8_SB(1, 0), cB + kstep); PG8_STAGEA(PG8_SA(1, 0), cA + kstep, vC, 0); PG8_STAGEB(PG8_SB(1, 1), cB + hstep + kstep);
    PG8_WAIT_V(6); PG8_BAR;
    for (;;) {
        const bool has_next = S.next(ui + 1, nxt);
        const char* nA = has_next ? nxt.A : cA; const char* nB = has_next ? nxt.B : cB;
        if constexpr (GATHER) { if (has_next) PG8_SETA(vN, nxt); else {
#pragma unroll
            for (int _h = 0; _h < 2; ++_h)
#pragma unroll
                for (int _i = 0; _i < 2; ++_i) vN[_h][_i] = vC[_h][_i]; } }
        for (int t = 0; t < nt; t += 2) {
            if constexpr (MID) { if (t == nt / 2) E.mid(acc, cur, wr, fr, ui); }
            const bool last = (t == nt - 2);
            const char* a1 = cA + (size_t)(t + 1) * kstep;
            const char* a2 = last ? nA : cA + (size_t)(t + 2) * kstep; const char* b2 = last ? nB : cB + (size_t)(t + 2) * kstep;
            const char* a3 = a2 + kstep; const char* b3 = b2 + kstep;
            unsigned v2[2][2];
#pragma unroll
            for (int _h = 0; _h < 2; ++_h)
#pragma unroll
                for (int _i = 0; _i < 2; ++_i) { if constexpr (GATHER) v2[_h][_i] = last ? vN[_h][_i] : vC[_h][_i]; else v2[_h][_i] = vC[_h][_i]; }
            PG8_LDB(B0, 0, 0); PG8_LDB(B1, 0, 1); PG8_SCHED; PG8_LDA(At, 0, 0); PG8_STAGEA(PG8_SA(1, 1), a1, vC, 1);
            PG8_WAIT_V(8); PG8_WAIT_L(0); PG8_BAR; PG8_MMA(0, 0, At, B0); PG8_MMA(0, 1, At, B1); PG8_BAR; PG8_SCHED;
            PG8_LDA(At, 0, 1); PG8_STAGEB(PG8_SB(0, 0), b2); PG8_STAGEB(PG8_SB(0, 1), b2 + hstep); PG8_STAGEA(PG8_SA(0, 0), a2, v2, 0);
            PG8_WAIT_V(8); PG8_WAIT_L(0); PG8_BAR; PG8_MMA(1, 0, At, B0); PG8_MMA(1, 1, At, B1); PG8_BAR; PG8_SCHED;
            PG8_LDB(B0, 1, 0); PG8_LDB(B1, 1, 1); PG8_SCHED; PG8_LDA(At, 1, 0); PG8_STAGEA(PG8_SA(0, 1), a2, v2, 1);
            PG8_WAIT_V(8); PG8_WAIT_L(0); PG8_BAR; PG8_MMA(0, 0, At, B0); PG8_MMA(0, 1, At, B1); PG8_BAR; PG8_SCHED;
            PG8_LDA(At, 1, 1); PG8_STAGEB(PG8_SB(1, 0), b3); PG8_STAGEB(PG8_SB(1, 1), b3 + hstep); PG8_STAGEA(PG8_SA(1, 0), a3, v2, 0);
            PG8_WAIT_V(8); PG8_WAIT_L(0); PG8_BAR; PG8_MMA(1, 0, At, B0); PG8_MMA(1, 1, At, B1); PG8_BAR; PG8_SCHED;
        }
        if constexpr (ALIGN_EPI) { if (wr == 0) PG8_BAR; }
        E(acc, cur, wr, wc, fr, fq);
        if (!has_next) break;
#pragma unroll
        for (int a = 0; a < 2; ++a)
#pragma unroll
            for (int b = 0; b < 2; ++b)
#pragma unroll
                for (int m = 0; m < 4; ++m)
#pragma unroll
                    for (int n = 0; n < 2; ++n) acc[a][b][m][n] = (f32x4){0.f, 0.f, 0.f, 0.f};
        cur = nxt; cA = nA; cB = nB; ++ui;
        if constexpr (GATHER) {
#pragma unroll
            for (int _h = 0; _h < 2; ++_h)
#pragma unroll
                for (int _i = 0; _i < 2; ++_i) vC[_h][_i] = vN[_h][_i]; }
        if constexpr (ALIGN_EPI) { if (wr == 1) PG8_BAR; }
    }
    PG8_WAIT_V(0);
    if constexpr (!ALIGN_EPI) { if (wr == 0) PG8_BAR; }
    PG8_BAR;
#undef PG8_SA
#undef PG8_SB
#undef PG8_STAGEA
#undef PG8_STAGEB
#undef PG8_LDA
#undef PG8_LDB
#undef PG8_MMA
#undef PG8_WAIT_V
#undef PG8_WAIT_L
#undef PG8_BAR
#undef PG8_SCHED
#undef PG8_SETA
}

template <class Epi, class Sched, bool GATHER, bool ALIGN_EPI>
__device__ __forceinline__ void gemm_phase8(LAS unsigned char* lds, const int KB, const Sched& S, const Epi& E) {
    const int tid = threadIdx.x, wid = __builtin_amdgcn_readfirstlane(tid >> 6), lane = tid & 63, wr = wid >> 2, wc = wid & 3, fr = lane & 15, fq = lane >> 4;
    const int nt = KB / 128;
    unsigned voffB[2]; int RA[2], CA[2];
#pragma unroll
    for (int i = 0; i < 2; ++i) { int R, C; stage_rc(tid * 16 + i * 8192, R, C); const int Rb = (R & ~31) + perm32(R & 31); RA[i] = R; CA[i] = C; voffB[i] = (unsigned)(Rb * KB + C * 2); }
    const size_t kstep = (size_t)(BK * 2);
    const size_t hstep = (size_t)HALF * KB;
    const unsigned ldsw = (unsigned)wid * 1024u;
    const int aoff = lds_byte(wr * 64 + fr, fq * 8), boff = lds_byte(wc * 32 + fr, fq * 8);
#define PG8_SA(b, h) (((b) * 2 + (h)) * HTB)
#define PG8_SB(b, h) ((4 + (b) * 2 + (h)) * HTB)
#define PG8_STAGEB(bufoff, gbase) do { _Pragma("unroll") for (int _i = 0; _i < 2; ++_i) \
        __builtin_amdgcn_global_load_lds((const unsigned*)((const char*)(gbase) + voffB[_i]), (LAS unsigned*)(lds + (bufoff) + ldsw + _i * 8192), 16, 0, 0); } while (0)
#define PG8_STAGEA(bufoff, gbase, vo, h) do { _Pragma("unroll") for (int _i = 0; _i < 2; ++_i) \
        __builtin_amdgcn_global_load_lds((const unsigned*)((const char*)(gbase) + (vo)[h][_i]), (LAS unsigned*)(lds + (bufoff) + ldsw + _i * 8192), 16, 0, 0); } while (0)
#define PG8_LDA(dst, b, h) do { _Pragma("unroll") for (int m = 0; m < 4; ++m) { const bf16x8 lo_ = *(const LAS bf16x8*)(lds + PG8_SA(b, h) + aoff + m * 2048), hi_ = *(const LAS bf16x8*)(lds + PG8_SA(b, h) + aoff + m * 2048 + 1024); dst[m] = __builtin_bit_cast(v8i, __builtin_shufflevector(lo_, hi_, 0, 1, 2, 3, 4, 5, 6, 7, 8, 9, 10, 11, 12, 13, 14, 15)); } } while (0)
#define PG8_LDB(dst, b, h) do { _Pragma("unroll") for (int n = 0; n < 2; ++n) { const bf16x8 lo_ = *(const LAS bf16x8*)(lds + PG8_SB(b, h) + boff + n * 2048), hi_ = *(const LAS bf16x8*)(lds + PG8_SB(b, h) + boff + n * 2048 + 1024); dst[n] = __builtin_bit_cast(v8i, __builtin_shufflevector(lo_, hi_, 0, 1, 2, 3, 4, 5, 6, 7, 8, 9, 10, 11, 12, 13, 14, 15)); } } while (0)
#define PG8_MMA(ai, bj, At, Bt) do { __builtin_amdgcn_s_setprio(1); _Pragma("unroll") for (int m = 0; m < 4; ++m) _Pragma("unroll") for (int n = 0; n < 2; ++n) \
        asm volatile("v_mfma_f32_16x16x128_f8f6f4 %0, %1, %2, %0" : "+v"(acc[ai][bj][m][n]) : "v"(Bt[n]), "v"(At[m])); __builtin_amdgcn_s_setprio(0); } while (0)
#define PG8_WAIT_V(n) asm volatile("s_waitcnt vmcnt(" #n ")" ::: "memory")
#define PG8_WAIT_L(n) asm volatile("s_waitcnt lgkmcnt(" #n ")" ::: "memory")
#define PG8_BAR __builtin_amdgcn_s_barrier()
#define PG8_SCHED __builtin_amdgcn_sched_barrier(0)
#define PG8_SETA(vo, u) do { _Pragma("unroll") for (int _h = 0; _h < 2; ++_h) _Pragma("unroll") for (int _i = 0; _i < 2; ++_i) { \
        if constexpr (GATHER) (vo)[_h][_i] = (unsigned)S.row((u).pm * BM + _h * HALF + RA[_i]) * (unsigned)KB + (unsigned)(CA[_i] * 2); \
        else (vo)[_h][_i] = (unsigned)((_h * HALF + RA[_i]) * KB + CA[_i] * 2); } } while (0)
    Unit cur, nxt; int ui = 0;
    if (!S.next(0, cur)) return;
    f32x4 acc[2][2][4][2];
#pragma unroll
    for (int a = 0; a < 2; ++a)
#pragma unroll
        for (int b = 0; b < 2; ++b)
#pragma unroll
            for (int m = 0; m < 4; ++m)
#pragma unroll
                for (int n = 0; n < 2; ++n) acc[a][b][m][n] = (f32x4){0.f, 0.f, 0.f, 0.f};
    v8i At[4], B0[2], B1[2];
    unsigned vC[2][2], vN[2][2];
    PG8_SETA(vC, cur);
    const char* cA = cur.A; const char* cB = cur.B;
    PG8_STAGEB(PG8_SB(0, 0), cB); PG8_STAGEB(PG8_SB(0, 1), cB + hstep); PG8_STAGEA(PG8_SA(0, 0), cA, vC, 0); PG8_STAGEA(PG8_SA(0, 1), cA, vC, 1);
    if (wr == 1) PG8_BAR;
    PG8_WAIT_V(2); PG8_BAR;
    PG8_STAGEB(PG8_SB(1, 0), cB + kstep); PG8_STAGEA(PG8_SA(1, 0), cA + kstep, vC, 0); PG8_STAGEB(PG8_SB(1, 1), cB + hstep + kstep);
    PG8_WAIT_V(6); PG8_BAR;
    for (;;) {
        const bool has_next = S.next(ui + 1, nxt);
        const char* nA = has_next ? nxt.A : cA; const char* nB = has_next ? nxt.B : cB;
        if constexpr (GATHER) { if (has_next) PG8_SETA(vN, nxt); else {
#pragma unroll
            for (int _h = 0; _h < 2; ++_h)
#pragma unroll
                for (int _i = 0; _i < 2; ++_i) vN[_h][_i] = vC[_h][_i]; } }
        for (int t = 0; t < nt; t += 2) {
            const bool last = (t == nt - 2);
            const char* a1 = cA + (size_t)(t + 1) * kstep;
            const char* a2 = last ? nA : cA + (size_t)(t + 2) * kstep; const char* b2 = last ? nB : cB + (size_t)(t + 2) * kstep;
            const char* a3 = a2 + kstep; const char* b3 = b2 + kstep;
            unsigned v2[2][2];
#pragma unroll
            for (int _h = 0; _h < 2; ++_h)
#pragma unroll
                for (int _i = 0; _i < 2; ++_i) { if constexpr (GATHER) v2[_h][_i] = last ? vN[_h][_i] : vC[_h][_i]; else v2[_h][_i] = vC[_h][_i]; }
            PG8_LDB(B0, 0, 0); PG8_LDB(B1, 0, 1); PG8_SCHED; PG8_LDA(At, 0, 0); PG8_STAGEA(PG8_SA(1, 1), a1, vC, 1);
            PG8_WAIT_V(8); PG8_WAIT_L(0); PG8_BAR; PG8_MMA(0, 0, At, B0); PG8_MMA(0, 1, At, B1); PG8_BAR; PG8_SCHED;
            PG8_LDA(At, 0, 1); PG8_STAGEB(PG8_SB(0, 0), b2); PG8_STAGEB(PG8_SB(0, 1), b2 + hstep); PG8_STAGEA(PG8_SA(0, 0), a2, v2, 0);
            PG8_WAIT_V(8); PG8_WAIT_L(0); PG8_BAR; PG8_MMA(1, 0, At, B0); PG8_MMA(1, 1, At, B1); PG8_BAR; PG8_SCHED;
            PG8_LDB(B0, 1, 0); PG8_LDB(B1, 1, 1); PG8_SCHED; PG8_LDA(At, 1, 0); PG8_STAGEA(PG8_SA(0, 1), a2, v2, 1);
            PG8_WAIT_V(8); PG8_WAIT_L(0); PG8_BAR; PG8_MMA(0, 0, At, B0); PG8_MMA(0, 1, At, B1); PG8_BAR; PG8_SCHED;
            PG8_LDA(At, 1, 1); PG8_STAGEB(PG8_SB(1, 0), b3); PG8_STAGEB(PG8_SB(1, 1), b3 + hstep); PG8_STAGEA(PG8_SA(1, 0), a3, v2, 0);
            PG8_WAIT_V(8); PG8_WAIT_L(0); PG8_BAR; PG8_MMA(1, 0, At, B0); PG8_MMA(1, 1, At, B1); PG8_BAR; PG8_SCHED;
        }
        if constexpr (ALIGN_EPI) { if (wr == 0) PG8_BAR; }
        asm volatile("s_nop 15\n\ts_nop 15" ::: "memory");
        E(acc, cur, wr, wc, fr, fq, ui);
        if (!has_next) break;
#pragma unroll
        for (int a = 0; a < 2; ++a)
#pragma unroll
            for (int b = 0; b < 2; ++b)
#pragma unroll
                for (int m = 0; m < 4; ++m)
#pragma unroll
                    for (int n = 0; n < 2; ++n) acc[a][b][m][n] = (f32x4){0.f, 0.f, 0.f, 0.f};
        cur = nxt; cA = nA; cB = nB; ++ui;
        if constexpr (GATHER) {
#pragma unroll
            for (int _h = 0; _h < 2; ++_h)
#pragma unroll
                for (int _i = 0; _i < 2; ++_i) vC[_h][_i] = vN[_h][_i]; }
        if constexpr (ALIGN_EPI) { if (wr == 1) PG8_BAR; }
    }
    PG8_WAIT_V(0);
    if constexpr (!ALIGN_EPI) { if (wr == 0) PG8_BAR; }
    PG8_BAR;
#undef PG8_SA
#undef PG8_SB
#undef PG8_STAGEA
#undef PG8_STAGEB
#undef PG8_LDA
#undef PG8_LDB
#undef PG8_MMA
#undef PG8_WAIT_V
#undef PG8_WAIT_L
#undef PG8_BAR
#undef PG8_SCHED
#undef PG8_SETA
}


__device__ __forceinline__ void head_norm(f32x4 (&acc)[2][2][4][2], LAS float* part, const float* gain, const LAS float* epsrow, int wr, int wc, int fr, int fq) {
#pragma unroll
    for (int ai = 0; ai < 2; ++ai)
#pragma unroll
        for (int m = 0; m < 4; ++m) { const int rl = ai * HALF + wr * 64 + m * 16 + fr;
#pragma unroll
            for (int bj = 0; bj < 2; ++bj) { const f32x4 a = acc[ai][bj][m][0], b = acc[ai][bj][m][1];
                float sq = (a[0] * a[0] + a[1] * a[1]) + (a[2] * a[2] + a[3] * a[3]) + (b[0] * b[0] + b[1] * b[1]) + (b[2] * b[2] + b[3] * b[3]);
                sq += __shfl_xor(sq, 16); sq += __shfl_xor(sq, 32);
                if (fq == 0) part[(rl * 2 + bj) * 4 + wc] = sq; } }
    asm volatile("s_waitcnt lgkmcnt(0)" ::: "memory"); __builtin_amdgcn_s_barrier(); asm volatile("" ::: "memory");
    const f32x4 g0 = *(const f32x4*)(gain + wc * 32 + 8 * fq), g1 = *(const f32x4*)(gain + wc * 32 + 8 * fq + 4);
#pragma unroll
    for (int ai = 0; ai < 2; ++ai)
#pragma unroll
        for (int m = 0; m < 4; ++m) { const int rl = ai * HALF + wr * 64 + m * 16 + fr; const float eps = epsrow ? epsrow[rl] : EPS;
#pragma unroll
            for (int bj = 0; bj < 2; ++bj) { const f32x4 p = *(const LAS f32x4*)(part + (rl * 2 + bj) * 4);
                const float rs = 1.f / sqrtf(((p[0] + p[1]) + (p[2] + p[3])) * (1.f / 128.f) + eps);
                acc[ai][bj][m][0] = acc[ai][bj][m][0] * rs * g0; acc[ai][bj][m][1] = acc[ai][bj][m][1] * rs * g1; } }
}
__device__ __forceinline__ void store_tile_bf16(const f32x4 (&acc)[2][2][4][2], bf16* O, int ldc, int row0, int col0) {
#pragma unroll
    for (int ai = 0; ai < 2; ++ai)
#pragma unroll
        for (int m = 0; m < 4; ++m) { bf16* rowp = O + (size_t)(row0 + ai * HALF + m * 16) * ldc + col0;
#pragma unroll
            for (int bj = 0; bj < 2; ++bj) { const f32x4 v0 = acc[ai][bj][m][0], v1 = acc[ai][bj][m][1]; v4u w; w.x = cvt_pk_bf16(v0[0], v0[1]); w.y = cvt_pk_bf16(v0[2], v0[3]); w.z = cvt_pk_bf16(v1[0], v1[1]); w.w = cvt_pk_bf16(v1[2], v1[3]);
                *(v4u*)(rowp + bj * HALF) = w; } }
}
struct EpiProj { bf16* O; const float* gq; const float* gk; LAS float* part;
    __device__ __forceinline__ void operator()(f32x4 (&acc)[2][2][4][2], const Unit& u, int wr, int wc, int fr, int fq) const {
        const bool prod = u.pn >= 4 && u.pn < 12;
        if (prod) {
#pragma unroll
            for (int ai = 0; ai < 2; ++ai)
#pragma unroll
                for (int m = 0; m < 4; ++m) { acc[ai][0][m][0] *= acc[ai][1][m][0]; acc[ai][0][m][1] *= acc[ai][1][m][1]; } }
        if (u.pn >= 12 && u.pn < 20) head_norm(acc, part, u.pn < 16 ? gq : gk, nullptr, wr, wc, fr, fq);
        const int row0 = u.pm * BM + wr * 64 + fr, col0 = (prod ? 1024 + (u.pn - 4) * HALF : u.pn * BM) + wc * 32 + 8 * fq;
#pragma unroll
        for (int ai = 0; ai < 2; ++ai)
#pragma unroll
            for (int m = 0; m < 4; ++m) { bf16* rowp = O + (size_t)(row0 + ai * HALF + m * 16) * NPROJ + col0;
#pragma unroll
                for (int bj = 0; bj < 2; ++bj) { const f32x4 v0 = acc[ai][bj][m][0], v1 = acc[ai][bj][m][1]; v4u w; w.x = cvt_pk_bf16(v0[0], v0[1]); w.y = cvt_pk_bf16(v0[2], v0[3]); w.z = cvt_pk_bf16(v1[0], v1[1]); w.w = cvt_pk_bf16(v1[2], v1[3]);
                    if (bj == 0 || !prod) *(v4u*)(rowp + bj * HALF) = w; } }
    }
};

struct EpiXProj { bf16* Q; bf16* KV; const float* gxq; const float* gxk; const float* ss1; LAS float* part;
    __device__ __forceinline__ void operator()(f32x4 (&acc)[2][2][4][2], const Unit& u, int wr, int wc, int fr, int fq) const {
        const bool second = u.pm >= 64; const int pm = second ? u.pm - 64 : u.pm; LAS float* epsrow = part + 2048;
        if (!second && threadIdx.x < 256) { const f32x4* p4 = (const f32x4*)(ss1 + (size_t)(pm * BM + threadIdx.x) * 32); f32x4 a = p4[0];
#pragma unroll
            for (int j = 1; j < 8; ++j) a += p4[j];
            epsrow[threadIdx.x] = EPS * (((a[0] + a[1]) + (a[2] + a[3])) * (1.f / 2048.f) + EPS); }
        if (!second || u.pn < 2) head_norm(acc, part, second ? gxk : gxq, second ? (const LAS float*)nullptr : (const LAS float*)epsrow, wr, wc, fr, fq);
        store_tile_bf16(acc, second ? KV : Q, second ? 1024 : XW, pm * BM + wr * 64 + fr, u.pn * BM + wc * 32 + 8 * fq);
    }
};


struct EpiRes1 { const float* RS0; const float* GM; bf16* X1; float* SS1; const float* SSF; const LAS float* rl;
    __device__ __forceinline__ void mid(f32x4 (&acc)[2][2][4][2], const Unit& u, int wr, int fr, int ui) const {
#pragma unroll
        for (int ai = 0; ai < 2; ++ai)
#pragma unroll
            for (int m = 0; m < 4; ++m) { const float rs = rl[ui * 256 + ai * HALF + wr * 64 + m * 16 + fr];
#pragma unroll
                for (int bj = 0; bj < 2; ++bj) { acc[ai][bj][m][0] *= rs; acc[ai][bj][m][1] *= rs; } }
    }
    __device__ __forceinline__ void operator()(const f32x4 (&acc)[2][2][4][2], const Unit& u, int wr, int wc, int fr, int fq) const {
        int fr_ = fr, fq_ = fq; asm volatile("" : "+v"(fr_), "+v"(fq_));
        const int row0 = u.pm * BM + wr * 64 + fr_, col0 = u.pn * BM + wc * 32 + 8 * fq_;
        f32x4 gi[2][2];
#pragma unroll
        for (int bj = 0; bj < 2; ++bj)
#pragma unroll
            for (int k = 0; k < 2; ++k) { const f32x4 g = *(const f32x4*)(GM + col0 + bj * HALF + 4 * k); gi[bj][k] = (f32x4){1.f / g[0], 1.f / g[1], 1.f / g[2], 1.f / g[3]}; }
        float qs[2][4];
#pragma unroll
        for (int ai = 0; ai < 2; ++ai)
#pragma unroll
            for (int m = 0; m < 4; ++m) qs[ai][m] = RS0[row0 + ai * HALF + m * 16];
#pragma unroll
        for (int ai = 0; ai < 2; ++ai) {
            v4u hw[4][2]; float sq[4] = {0.f, 0.f, 0.f, 0.f};
#pragma unroll
            for (int m = 0; m < 4; ++m) { const int row = row0 + ai * HALF + m * 16;
#pragma unroll
                for (int bj = 0; bj < 2; ++bj) hw[m][bj] = *(const v4u*)(X1 + (size_t)row * DM + col0 + bj * HALF); }
#pragma unroll
            for (int bj = 0; bj < 2; ++bj) {
#pragma unroll
                for (int m = 0; m < 4; ++m) { const int row = row0 + ai * HALF + m * 16; float hf[8]; unpack8(hw[m][bj], hf);
                    const f32x4 v0 = (f32x4){hf[0], hf[1], hf[2], hf[3]} * qs[ai][m] * gi[bj][0] + acc[ai][bj][m][0], v1 = (f32x4){hf[4], hf[5], hf[6], hf[7]} * qs[ai][m] * gi[bj][1] + acc[ai][bj][m][1];
                    sq[m] += (v0[0] * v0[0] + v0[1] * v0[1]) + (v0[2] * v0[2] + v0[3] * v0[3]) + (v1[0] * v1[0] + v1[1] * v1[1]) + (v1[2] * v1[2] + v1[3] * v1[3]);
                    v4u w; w.x = cvt_pk_bf16(v0[0], v0[1]); w.y = cvt_pk_bf16(v0[2], v0[3]); w.z = cvt_pk_bf16(v1[0], v1[1]); w.w = cvt_pk_bf16(v1[2], v1[3]);
                    *(v4u*)(X1 + (size_t)row * DM + col0 + bj * HALF) = w; } }
#pragma unroll
            for (int m = 0; m < 4; ++m) { const int row = row0 + ai * HALF + m * 16; float q = sq[m]; q += __shfl_xor(q, 16); q += __shfl_xor(q, 32);
                if (fq == 0) SS1[(size_t)row * 32 + u.pn * 4 + wc] = q; } }
    }
};
struct EpiRes2 { bf16* X; float* SS2; unsigned char* X8; const float* gmoe;
    __device__ __forceinline__ void operator()(const f32x4 (&acc)[2][2][4][2], const Unit& u, int wr, int wc, int fr, int fq) const {
        const int row0 = u.pm * BM + wr * 64 + fr, col0 = u.pn * BM + wc * 32 + 8 * fq;
        f32x4 gm[2][2];
#pragma unroll
        for (int bj = 0; bj < 2; ++bj) { gm[bj][0] = *(const f32x4*)(gmoe + col0 + bj * HALF); gm[bj][1] = *(const f32x4*)(gmoe + col0 + bj * HALF + 4); }
#pragma unroll
        for (int ai = 0; ai < 2; ++ai) {
            v4u xall[4][2];
#pragma unroll
            for (int m = 0; m < 4; ++m)
#pragma unroll
                for (int bj = 0; bj < 2; ++bj) xall[m][bj] = *(const v4u*)(X + (size_t)(row0 + ai * HALF + m * 16) * DM + col0 + bj * HALF);
#pragma unroll
            for (int m = 0; m < 4; ++m) { const int row = row0 + ai * HALF + m * 16; const size_t off = (size_t)row * DM + col0; float sq = 0.f;
#pragma unroll
                for (int bj = 0; bj < 2; ++bj) { const v4u xw = xall[m][bj];
                    const f32x4 x0 = {lo16(xw.x), hi16(xw.x), lo16(xw.y), hi16(xw.y)}, x1 = {lo16(xw.z), hi16(xw.z), lo16(xw.w), hi16(xw.w)};
                    const f32x4 v0 = x0 + acc[ai][bj][m][0], v1 = x1 + acc[ai][bj][m][1];
                    sq += (v0[0] * v0[0] + v0[1] * v0[1]) + (v0[2] * v0[2] + v0[3] * v0[3]) + (v1[0] * v1[0] + v1[1] * v1[1]) + (v1[2] * v1[2] + v1[3] * v1[3]);
                    v4u w; w.x = cvt_pk_bf16(v0[0], v0[1]); w.y = cvt_pk_bf16(v0[2], v0[3]); w.z = cvt_pk_bf16(v1[0], v1[1]); w.w = cvt_pk_bf16(v1[2], v1[3]);
                    *(v4u*)(X + off + bj * HALF) = w;
                    const f32x4 h0 = v0 * gm[bj][0], h1 = v1 * gm[bj][1]; v2u w8; w8.x = pk4_fp8(h0[0], h0[1], h0[2], h0[3]); w8.y = pk4_fp8(h1[0], h1[1], h1[2], h1[3]);
                    *(v2u*)(X8 + off + bj * HALF) = w8; }
                sq += __shfl_xor(sq, 16); sq += __shfl_xor(sq, 32);
                if (fq == 0) SS2[(size_t)row * 32 + u.pn * 4 + wc] = sq; } }
    }
};
constexpr float W8_SCALE = 64.f, W8_INV = 1.f / 64.f;
__device__ __forceinline__ v4u widen_pair(v2u wa, v2u wb, bool odd) {
    const v2u snd = odd ? wa : wb, kp = odd ? wb : wa; v2u rc; rc.x = (unsigned)__shfl_xor((int)snd.x, 16); rc.y = (unsigned)__shfl_xor((int)snd.y, 16);
    v4u o; if (odd) { o.x = rc.x; o.y = rc.y; o.z = kp.x; o.w = kp.y; } else { o.x = kp.x; o.y = kp.y; o.z = rc.x; o.w = rc.y; } return o;
}
typedef float f32x2 __attribute__((ext_vector_type(2)));
__device__ __forceinline__ f32x2 swiglu_pk(f32x2 g, f32x2 u) {
    g.x = fminf(g.x, SW_LIMIT); g.y = fminf(g.y, SW_LIMIT); u.x = __builtin_amdgcn_fmed3f(u.x, -SW_LIMIT, SW_LIMIT); u.y = __builtin_amdgcn_fmed3f(u.y, -SW_LIMIT, SW_LIMIT);
    const f32x2 a = g * (-SW_ALPHA * 1.4426950408889634f); f32x2 e; e.x = __builtin_amdgcn_exp2f(a.x); e.y = __builtin_amdgcn_exp2f(a.y);
    const f32x2 d = e + 1.0f; f32x2 r; r.x = __builtin_amdgcn_rcpf(d.x); r.y = __builtin_amdgcn_rcpf(d.y);
    return ((u + 1.0f) * g) * r;
}
struct EpiGlu8 { unsigned char* O; const float* bgu; const LAS short* tile_e; const float* rss; const LAS float* rl;
    __device__ __forceinline__ void operator()(const f32x4 (&acc)[2][2][4][2], const Unit& u, int wr, int wc, int fr, int fq, int ui) const {
        const int e = __builtin_amdgcn_readfirstlane(tile_e[u.pm]); const int row0 = u.pm * BM + wr * 64 + fr, col0 = u.pn * HALF + wc * 32 + 8 * fq;
        const float* bg = bgu + (size_t)e * 4096 + col0;
        const f32x4 g0 = *(const f32x4*)bg, g1 = *(const f32x4*)(bg + 4), u0 = *(const f32x4*)(bg + DFF), u1 = *(const f32x4*)(bg + DFF + 4);
        const bool odd = fq & 1;
#pragma unroll
        for (int ai = 0; ai < 2; ++ai) { v2u wm[4];
#pragma unroll
            for (int m = 0; m < 4; ++m) { const int rr = wr * 64 + fr + ai * HALF + m * 16; const float rs = rl[ui * 256 + rr] * W8_INV;
                const f32x4 a0 = acc[ai][0][m][0] * rs + g0, a1 = acc[ai][0][m][1] * rs + g1, b0 = acc[ai][1][m][0] * rs + u0, b1 = acc[ai][1][m][1] * rs + u1;
                const f32x2 s0 = swiglu_pk((f32x2){a0[0], a0[1]}, (f32x2){b0[0], b0[1]}), s1 = swiglu_pk((f32x2){a0[2], a0[3]}, (f32x2){b0[2], b0[3]});
                const f32x2 s2 = swiglu_pk((f32x2){a1[0], a1[1]}, (f32x2){b1[0], b1[1]}), s3 = swiglu_pk((f32x2){a1[2], a1[3]}, (f32x2){b1[2], b1[3]});
                wm[m].x = pk4_fp8(s0.x, s0.y, s1.x, s1.y); wm[m].y = pk4_fp8(s2.x, s2.y, s3.x, s3.y); }
#pragma unroll
            for (int mp = 0; mp < 2; ++mp) { const v4u o = widen_pair(wm[2 * mp], wm[2 * mp + 1], odd);
                *(v4u*)(O + (size_t)(row0 + ai * HALF + (2 * mp + (odd ? 1 : 0)) * 16) * DFF + col0 - (odd ? 8 : 0)) = o; } }
    }
};

constexpr float Y8_SCALE = 8.f, Y8_INV = 1.f / 8.f;
struct EpiBiasFp8 { unsigned char* O; const float* bdn; const LAS short* tile_e;
    __device__ __forceinline__ void operator()(const f32x4 (&acc)[2][2][4][2], const Unit& u, int wr, int wc, int fr, int fq, int) const {
        const int e = __builtin_amdgcn_readfirstlane(tile_e[u.pm]); const int row0 = u.pm * BM + wr * 64 + fr, col0 = u.pn * BM + wc * 32 + 8 * fq;
        const float* bb = bdn + (size_t)e * DM + col0; f32x4 bv[2][2];
#pragma unroll
        for (int bj = 0; bj < 2; ++bj) { bv[bj][0] = *(const f32x4*)(bb + bj * HALF) * Y8_SCALE; bv[bj][1] = *(const f32x4*)(bb + bj * HALF + 4) * Y8_SCALE; }
        const bool odd = fq & 1;
#pragma unroll
        for (int ai = 0; ai < 2; ++ai)
#pragma unroll
            for (int bj = 0; bj < 2; ++bj) { v2u wm[4];
#pragma unroll
                for (int m = 0; m < 4; ++m) { const f32x4 v0 = acc[ai][bj][m][0] * (W8_INV * Y8_SCALE) + bv[bj][0], v1 = acc[ai][bj][m][1] * (W8_INV * Y8_SCALE) + bv[bj][1];
                    wm[m].x = pk4_fp8(v0[0], v0[1], v0[2], v0[3]); wm[m].y = pk4_fp8(v1[0], v1[1], v1[2], v1[3]); }
#pragma unroll
                for (int mp = 0; mp < 2; ++mp) { const v4u o = widen_pair(wm[2 * mp], wm[2 * mp + 1], odd);
                    *(v4u*)(O + (size_t)(row0 + ai * HALF + (2 * mp + (odd ? 1 : 0)) * 16) * DM + col0 + bj * HALF - (odd ? 8 : 0)) = o; } }
    }
};

struct DualOrder { int n1, nN1, n2, nN2, pm_split, G, c; const char* A1; const char* B1; const char* A2; const char* B2; size_t tstep;
    __device__ __forceinline__ bool next(int i, Unit& u) const { const int L = i * G + c; if (L >= n1 + n2) return false;
        if (L < n1) { u.pm = L / nN1; u.pn = L % nN1; u.A = A1 + (size_t)u.pm * tstep; u.B = B1 + (size_t)u.pn * tstep; }
        else { const int l = L - n1; const int pm = l / nN2; u.pn = l % nN2; u.pm = pm + pm_split; u.A = A2 + (size_t)pm * tstep; u.B = B2 + (size_t)u.pn * tstep; }
        return true; }
    __device__ __forceinline__ int row(int) const { return 0; }
};
struct MoeOrder { int nU, nN, G, c; const char* A; const char* B; size_t estride, tstep; const LAS short* tile_e; const int* list; bool gather;
    __device__ __forceinline__ bool next(int i, Unit& u) const { const int L = i * G + c; if (L >= nU) return false;
        u.pm = L / nN; u.pn = L % nN; const int e = __builtin_amdgcn_readfirstlane(tile_e[u.pm]); u.A = gather ? A : A + (size_t)u.pm * tstep; u.B = B + (size_t)e * estride + (size_t)u.pn * tstep; return true; }
    __device__ __forceinline__ int row(int r) const { return list[r]; }
};
}


namespace fa {
constexpr int D = 128, NW = 8, QBLK = 32, KVBLK = 64, QB = NW * QBLK;
constexpr int SHM_V = KVBLK * D * 2, SHM_K = KVBLK * D * 2;
constexpr int BIAS_OFF = 2 * SHM_V + 2 * SHM_K + NW * 64 * 4;
constexpr int LDS_BYTES = BIAS_OFF + 2048 * 4;
constexpr int SSQ_OFF = 81920;
constexpr float SCALE = 0.08838834764831845f, THR = 8.f;
typedef short s16x4 __attribute__((ext_vector_type(4)));
typedef unsigned u32x4 __attribute__((ext_vector_type(4)));
#define KSWZ(row, colB) ((row) * 256 + ((colB) ^ (((row) & 7) << 4)))
#define SBAR() __builtin_amdgcn_sched_barrier(0)
__device__ __forceinline__ int v_st(int k, int c) { const int kk = (k & ~0xC) | ((k & 4) << 1) | ((k & 8) >> 1); return ((kk >> 3) * 4 + (c >> 5)) * 512 + ((kk & 7) * 32 + (c & 31)) * 2; }
__device__ __forceinline__ int v_rd_base(int lane) { return ((lane & 3) << 3) | (((lane >> 2) & 3) << 6) | (((lane >> 4) & 1) << 5) | (((lane >> 5) & 1) << 8); }
constexpr int v_rd_off(int d0, int ks, int half) { return d0 * 512 + ks * 4096 + half * 2048; }
__device__ __forceinline__ int crow(int r, int hi) { return (r & 3) + 8 * (r >> 2) + 4 * hi; }
__device__ __forceinline__ unsigned cvtpk(float lo, float hi) { unsigned r; asm volatile("v_cvt_pk_bf16_f32 %0, %1, %2" : "=v"(r) : "v"(lo), "v"(hi)); return r; }
__device__ __forceinline__ bf16x8 load8(const bf16* p) { return *reinterpret_cast<const bf16x8*>(p); }
__device__ __forceinline__ void mask_tile(f32x16& p0, f32x16& p1, int dq, unsigned W) {
    const float NEG = -__builtin_inff();
#pragma unroll
    for (int r = 0; r < 16; ++r) { const int c = (r & 3) + 8 * (r >> 2);
        if ((unsigned)(dq - c) >= W) p0[r] = NEG;
        if ((unsigned)(dq - c - 32) >= W) p1[r] = NEG; }
}
__device__ __forceinline__ void partialSM(f32x16& p0, f32x16& p1, float& m_reg, float& mn, float& alpha) {
    float pmax = p0[0]; for (int r = 1; r < 16; ++r) pmax = fmaxf(pmax, p0[r]); for (int r = 0; r < 16; ++r) pmax = fmaxf(pmax, p1[r]);
    { auto rr = __builtin_amdgcn_permlane32_swap(__float_as_uint(pmax), __float_as_uint(pmax), false, false);
      pmax = fmaxf(__uint_as_float(rr[0]), __uint_as_float(rr[1])); }
    constexpr float C2 = 1.4426950408889634f * SCALE;
    if (__builtin_expect(__all((pmax - m_reg) * SCALE <= THR), 1)) { mn = m_reg; alpha = 1.f; }
    else { mn = fmaxf(m_reg, pmax); alpha = __builtin_amdgcn_exp2f((m_reg - mn) * C2); m_reg = mn; }
    const float mnL = -mn * C2;
    for (int r = 0; r < 16; ++r) p0[r] = fmaf(p0[r], C2, mnL); for (int r = 0; r < 16; ++r) p1[r] = fmaf(p1[r], C2, mnL);
    for (int r = 0; r < 16; ++r) p0[r] = __builtin_amdgcn_exp2f(p0[r]);
}
__device__ __forceinline__ void finishSM(f32x16& p0, f32x16& p1, float alpha, float& l_reg, bf16x8& pa0, bf16x8& pa1, bf16x8& pa2, bf16x8& pa3) {
    for (int r = 0; r < 16; ++r) p1[r] = __builtin_amdgcn_exp2f(p1[r]);
    float ps = 0; for (int r = 0; r < 16; ++r) ps += p0[r]; for (int r = 0; r < 16; ++r) ps += p1[r];
    { auto rr = __builtin_amdgcn_permlane32_swap(__float_as_uint(ps), __float_as_uint(ps), false, false);
      ps = __uint_as_float(rr[0]) + __uint_as_float(rr[1]); }
    l_reg = l_reg * alpha + ps;
#define PK4(P, B_, OUT) do { unsigned a0 = cvtpk(P[B_+0], P[B_+1]), a1 = cvtpk(P[B_+2], P[B_+3]);                          \
        unsigned b0 = cvtpk(P[B_+4], P[B_+5]), b1 = cvtpk(P[B_+6], P[B_+7]);                                             \
        auto r0 = __builtin_amdgcn_permlane32_swap(a0, b0, false, false); auto r1 = __builtin_amdgcn_permlane32_swap(a1, b1, false, false); \
        u32x4 w = {r0[0], r1[0], r0[1], r1[1]}; OUT = *reinterpret_cast<bf16x8*>(&w); } while (0)
    PK4(p0, 0, pa0); PK4(p0, 8, pa1); PK4(p1, 0, pa2); PK4(p1, 8, pa3);
#undef PK4
}
template <int KB, bool BIAS>
__device__ __forceinline__ void qkt(f32x16& p0, f32x16& p1, const char* K_lds, const char* bias_t, int r32, int hi, const bf16x8* qr) {
    if constexpr (BIAS) {
#pragma unroll
        for (int g = 0; g < 4; ++g) { const f32x4 a = *reinterpret_cast<const f32x4*>(bias_t + (8 * g) * 4), b = *reinterpret_cast<const f32x4*>(bias_t + (32 + 8 * g) * 4);
            p0[4 * g] = a[0]; p0[4 * g + 1] = a[1]; p0[4 * g + 2] = a[2]; p0[4 * g + 3] = a[3]; p1[4 * g] = b[0]; p1[4 * g + 1] = b[1]; p1[4 * g + 2] = b[2]; p1[4 * g + 3] = b[3]; }
    } else { p0 = f32x16{}; p1 = f32x16{}; }
    const char* kb[4];
#pragma unroll
    for (int dd = 0; dd < 4; ++dd) kb[dd] = K_lds + KB * SHM_K + KSWZ(r32, (dd * 16 + hi * 8) * 2);
#pragma unroll
    for (int d0 = 0; d0 < 8; ++d0) { const char* a = kb[d0 & 3] + (d0 >> 2) * 128;
        bf16x8 b0 = *reinterpret_cast<const bf16x8*>(a);
        bf16x8 b1 = *reinterpret_cast<const bf16x8*>(a + 32 * 256);
        p0 = __builtin_amdgcn_mfma_f32_32x32x16_bf16(b0, qr[d0], p0, 0, 0, 0);
        p1 = __builtin_amdgcn_mfma_f32_32x32x16_bf16(b1, qr[d0], p1, 0, 0, 0); }
}
template <int VB>
__device__ __forceinline__ void pv_tile(f32x16* o, int vb0, bf16x8 pa0, bf16x8 pa1, bf16x8 pa2, bf16x8 pa3) {
#define TRRD(dst, off) asm volatile("ds_read_b64_tr_b16 %0, %1 offset:%2" : "=&v"(dst) : "v"(vb0), "i"(off) : "memory")
#define PV_D0(d0) do { s16x4 l0, l1, l2, l3, h0, h1, h2, h3; constexpr int b_ = VB * SHM_V + v_rd_off(d0, 0, 0); \
        TRRD(l0, b_); TRRD(h0, b_ + 2048); TRRD(l1, b_ + 4096); TRRD(h1, b_ + 6144); TRRD(l2, b_ + 8192); TRRD(h2, b_ + 10240); TRRD(l3, b_ + 12288); TRRD(h3, b_ + 14336); \
        asm volatile("s_waitcnt lgkmcnt(0)" ::: "memory"); SBAR();   \
        o[d0] = __builtin_amdgcn_mfma_f32_32x32x16_bf16(pa0, (bf16x8){l0[0], l0[1], l0[2], l0[3], h0[0], h0[1], h0[2], h0[3]}, o[d0], 0, 0, 0);   \
        o[d0] = __builtin_amdgcn_mfma_f32_32x32x16_bf16(pa1, (bf16x8){l1[0], l1[1], l1[2], l1[3], h1[0], h1[1], h1[2], h1[3]}, o[d0], 0, 0, 0);   \
        o[d0] = __builtin_amdgcn_mfma_f32_32x32x16_bf16(pa2, (bf16x8){l2[0], l2[1], l2[2], l2[3], h2[0], h2[1], h2[2], h2[3]}, o[d0], 0, 0, 0);   \
        o[d0] = __builtin_amdgcn_mfma_f32_32x32x16_bf16(pa3, (bf16x8){l3[0], l3[1], l3[2], l3[3], h3[0], h3[1], h3[2], h3[3]}, o[d0], 0, 0, 0); } while (0)
    PV_D0(0); PV_D0(1); PV_D0(2); PV_D0(3);
#undef PV_D0
#undef TRRD
}
struct BlockRef { const bf16* Q; const bf16* K; const bf16* V; bf16* O; int P0; };
struct Seam { bf16x8 qr[8]; bf16x8 st_v0, st_v1, st_k0, st_k1; };
__device__ __forceinline__ int swa_jlo(int P0, int W) { const int lowk = P0 - W + 1; return lowk > 0 ? lowk / KVBLK : 0; }
#define ROW(p, k0, rr) ((p) + (size_t)((k0) + (rr)) * KP + sc)
#define VMW() asm volatile("s_waitcnt vmcnt(0)" ::: "memory")
#define VMWN(n) asm volatile("s_waitcnt vmcnt(%0)" :: "i"(n) : "memory")
#define SLOAD_H(Kp, Vp, k0) do { S.st_v0 = load8(ROW(Vp, k0, sr)); S.st_v1 = load8(ROW(Vp, k0, 32 + sr));              \
                         S.st_k0 = load8(ROW(Kp, k0, sr)); S.st_k1 = load8(ROW(Kp, k0, 32 + sr)); } while (0)
#define SWRITE_HK(bf) do { *(bf16x8*)(K_lds + (bf) * SHM_K + kws) = S.st_k0; *(bf16x8*)(K_lds + (bf) * SHM_K + kws + 32 * 256) = S.st_k1; } while (0)
#define SWRITE_HV(bf) do { *(bf16x8*)(V_lds + (bf) * SHM_V + vst0) = S.st_v0; *(bf16x8*)(V_lds + (bf) * SHM_V + vst1) = S.st_v1; } while (0)
#define SWRITE_H(bf) do { SWRITE_HV(bf); SWRITE_HK(bf); } while (0)
template <int QP, int KP>
__device__ __forceinline__ void prime(const BlockRef& cur, int W, char* lds, Seam& S) {
    const int tid = threadIdx.x, wid = __builtin_amdgcn_readfirstlane(tid >> 6), lane = tid & 63, r32 = lane & 31, hi = lane >> 5;
    const int sr = tid >> 4, sc = (tid & 15) * 8, kws = KSWZ(sr, sc * 2); char* K_lds = lds + 2 * SHM_V;
    const int kb0 = swa_jlo(cur.P0, W) * KVBLK;
    for (int d0 = 0; d0 < 8; ++d0) S.qr[d0] = load8(cur.Q + (size_t)(wid * QBLK + r32) * QP + d0 * 16 + hi * 8);
    SLOAD_H(cur.K, cur.V, kb0); VMW(); SWRITE_HK(0);
    __syncthreads();
}
template <int QP, int KP, int OP, bool BIAS, bool CAUSAL, bool SSQ>
__device__ __forceinline__ void block(const BlockRef& cur, const BlockRef& nxt, int skv, int W, char* lds, Seam& S, const bf16* obase = nullptr, float* ssbase = nullptr) {
    const int tid = threadIdx.x, wid = __builtin_amdgcn_readfirstlane(tid >> 6), lane = tid & 63, r32 = lane & 31, hi = lane >> 5;
    const int j_lo = swa_jlo(cur.P0, W);
    int j_hi = (cur.P0 + QB - 1) / KVBLK + 1; if (j_hi > skv / KVBLK) j_hi = skv / KVBLK;
    const int NT = j_hi - j_lo;
    const int kbn = swa_jlo(nxt.P0, W) * KVBLK;
    const int qlo = cur.P0 + wid * QBLK, qm = qlo + r32 - 4 * hi;
    char* V_lds = lds; char* K_lds = lds + 2 * SHM_V;
    float* ws = (float*)(lds + 2 * SHM_V + 2 * SHM_K) + wid * 64; float* li_l = ws, * al_l = ws + 32;
    const char* bias_l = lds + BIAS_OFF + hi * 16;
    float m_reg = -1e30f, l_reg = 0; f32x16 o[4] = {};
    const int sr = tid >> 4, sc = (tid & 15) * 8, vst0 = v_st(sr, sc), vst1 = v_st(32 + sr, sc), kws = KSWZ(sr, sc * 2);
    const int vb0 = (int)(uintptr_t)V_lds + v_rd_base(lane);
    const bf16* Kh = cur.K; const bf16* Vh = cur.V;
#define RESC(a) do { if (__any((a) < 1.f)) { if (hi == 0) al_l[r32] = (a); asm volatile("s_waitcnt lgkmcnt(0)" ::: "memory");              \
                     for (int d_ = 0; d_ < 4; ++d_) for (int r = 0; r < 16; ++r) o[d_][r] *= al_l[crow(r, hi)]; } } while (0)
#define KBASE(t) ((j_lo + (t)) * KVBLK)
#define BIAS_T(t) (bias_l + KBASE(t) * 4)
#define MASKT(P0_, P1_, t) do { if constexpr (CAUSAL) { const int kb_ = KBASE(t); if (kb_ + KVBLK - 1 > qlo || kb_ <= qlo + QBLK - 1 - W) mask_tile(P0_, P1_, qm - kb_, (unsigned)W); } } while (0)
    constexpr int NQL = 8;
#define SEAM_K0() do { VMWN(NQL); SWRITE_HK(0); SBAR(); } while (0)
    f32x16 pA0, pA1, pB0, pB1; float mnA, mnB, alA, alB; bf16x8 pa0, pa1, pa2, pa3;
    SWRITE_HV(0); SBAR();
    if (NT > 1) { SLOAD_H(Kh, Vh, KBASE(1)); }
    SBAR(); qkt<0, BIAS>(pA0, pA1, K_lds, BIAS_T(0), r32, hi, S.qr);
    MASKT(pA0, pA1, 0); partialSM(pA0, pA1, m_reg, mnA, alA);
    if (NT > 1) { VMW(); SWRITE_H(1); }
    __syncthreads();
#define HALF_STEP(PX0, PX1, mnX, alX, PY0, PY1, alY, t, KB, VB, SB) do {                                                      \
        SBAR(); qkt<KB, BIAS>(PX0, PX1, K_lds, BIAS_T(t), r32, hi, S.qr);                                                    \
        finishSM(PY0, PY1, alY, l_reg, pa0, pa1, pa2, pa3); SBAR();                                                           \
        if ((t) + 1 < NT) { SLOAD_H(Kh, Vh, KBASE((t) + 1)); SBAR(); }                                                        \
        pv_tile<VB>(o, vb0, pa0, pa1, pa2, pa3); MASKT(PX0, PX1, (t)); partialSM(PX0, PX1, m_reg, mnX, alX);                   \
        __syncthreads();                                                                                                      \
        if ((t) + 1 < NT) { VMW(); SWRITE_H(SB); }                                                                           \
        RESC(alX); __syncthreads(); } while (0)
    for (int t = 1; t + 1 < NT; t += 2) {
        HALF_STEP(pB0, pB1, mnB, alB, pA0, pA1, alA, t, 1, 0, 0);
        HALF_STEP(pA0, pA1, mnA, alA, pB0, pB1, alB, t + 1, 0, 1, 1);
    }
    const bool even = (NT & 1) == 0;
    if (even) { SBAR(); qkt<1, BIAS>(pB0, pB1, K_lds, BIAS_T(NT - 1), r32, hi, S.qr); SBAR(); }
    SLOAD_H(nxt.K, nxt.V, kbn); SBAR();
#pragma unroll
    for (int d0 = 0; d0 < 8; ++d0) S.qr[d0] = load8(nxt.Q + (size_t)(wid * QBLK + r32) * QP + d0 * 16 + hi * 8);
    SBAR();
    finishSM(pA0, pA1, alA, l_reg, pa0, pa1, pa2, pa3); SBAR();
    pv_tile<0>(o, vb0, pa0, pa1, pa2, pa3);
    if (even) { MASKT(pB0, pB1, NT - 1); partialSM(pB0, pB1, m_reg, mnB, alB); __syncthreads(); RESC(alB);
        finishSM(pB0, pB1, alB, l_reg, pa0, pa1, pa2, pa3); SBAR(); pv_tile<1>(o, vb0, pa0, pa1, pa2, pa3); }
    SBAR(); SEAM_K0();
    if (hi == 0) li_l[r32] = l_reg; asm volatile("s_waitcnt lgkmcnt(0)" ::: "memory");
    float rli[16];
#pragma unroll
    for (int r = 0; r < 16; ++r) rli[r] = __builtin_amdgcn_rcpf(li_l[crow(r, hi)]);
    bf16* Ow = cur.O + (size_t)(wid * QBLK) * OP;
#pragma unroll
    for (int r = 0; r < 16; ++r) { const int orow = crow(r, hi); float sq = 0.f;
#pragma unroll
        for (int d0 = 0; d0 < 4; ++d0) { const float v = o[d0][r] * rli[r]; sq += v * v;
            const float vn = __shfl_xor(v, 1);
            if ((r32 & 1) == 0) *(unsigned*)(Ow + (size_t)orow * OP + d0 * 32 + r32) = cvtpk(v, vn); }
        if constexpr (SSQ) ((float*)(lds + SSQ_OFF))[(wid * 32 + hi * 16 + r) * 32 + r32] = sq; }
    if constexpr (SSQ) { const int L_ = lane & 31, hi_ = (L_ >> 2) & 1, r_ = (L_ & 3) + 4 * (L_ >> 3);
        const f32x4* p_ = (const f32x4*)((const float*)(lds + SSQ_OFF) + (wid * 32 + hi_ * 16 + r_) * 32); f32x4 a_ = p_[0];
#pragma unroll
        for (int j_ = 1; j_ < 8; ++j_) a_ += p_[j_];
        if (lane < 32) { const size_t idx_ = (size_t)(cur.O - obase); ssbase[(idx_ / OP + wid * QBLK + L_) * 8 + (idx_ % OP) / D] = (a_[0] + a_[1]) + (a_[2] + a_[3]); } }
    __syncthreads();
#undef RESC
#undef KBASE
#undef BIAS_T
#undef MASKT
#undef SEAM_K0
#undef HALF_STEP
}
#undef ROW
#undef VMW
#undef VMWN
#undef SLOAD_H
#undef SWRITE_HK
#undef SWRITE_HV
#undef SWRITE_H
#undef KSWZ
#undef SBAR
}


struct CvTile { const float* W; unsigned char* WT; int ldw, k0, n0, gu; };
__device__ __forceinline__ CvTile cv_decode(const Frame& F, int tile) {
    constexpr int TGU = 16 * 16, TDN = 16 * 8; CvTile t;
    if (tile < NE * TGU) { const int e = tile / TGU, q = tile % TGU; t.W = F.in[I_WGU] + (size_t)e * DM * 4096; t.WT = F.ws + WS_WGU + (size_t)e * 4096 * DM; t.ldw = 4096; t.k0 = (q >> 4) * 128; t.n0 = (q & 15) * 256; t.gu = 1; }
    else { const int r = tile - NE * TGU, e = r / TDN, q = r % TDN; t.W = F.in[I_WDN] + (size_t)e * DFF * DM; t.WT = F.ws + WS_WDN + (size_t)e * DM * DFF; t.ldw = DM; t.k0 = (q >> 3) * 128; t.n0 = (q & 7) * 256; t.gu = 0; }
    return t;
}
__device__ __forceinline__ void p0_moe_convert8(Frame& F) {
    constexpr int NTILES = NE * (16 * 16 + 16 * 8);
    LAS unsigned char* T8 = F.lds; const int tid = F.tid, lane = F.lane, w = F.wave;
#define CV_LOAD(ld, t) do { const float* p_ = (t).W + (size_t)((t).k0 + 16 * w) * (t).ldw + (t).n0 + 4 * lane; _Pragma("unroll") for (int q_ = 0; q_ < 16; ++q_) ld[q_] = __builtin_nontemporal_load((const f32x4*)(p_ + (size_t)q_ * (t).ldw)); } while (0)
#define CV_PROC(ld, t) do { \
        _Pragma("unroll") for (int s_ = 0; s_ < 4; ++s_) _Pragma("unroll") for (int i_ = 0; i_ < 4; ++i_) { \
            const unsigned d_ = pg8::pk4_fp8(ld[4 * s_][i_] * 64.f, ld[4 * s_ + 1][i_] * 64.f, ld[4 * s_ + 2][i_] * 64.f, ld[4 * s_ + 3][i_] * 64.f); \
            *(LAS unsigned*)(T8 + (4 * lane + i_) * 128 + ((w ^ (lane & 7)) * 16) + s_ * 4) = d_; } \
        __syncthreads(); \
        _Pragma("unroll") for (int j_ = 0; j_ < 4; ++j_) { const int p_ = tid + 512 * j_, n_ = p_ >> 3, c_ = p_ & 7; \
            const v4u v_ = *(const LAS v4u*)(T8 + n_ * 128 + ((c_ ^ ((n_ >> 2) & 7)) * 16)); const int nn_ = (t).n0 + n_; \
            const int dr_ = (t).gu ? ((nn_ & 2047) >> 7) * 256 + (nn_ >> 11) * 128 + (nn_ & 127) : nn_; \
            __builtin_nontemporal_store(v_, (v4u*)((t).WT + (size_t)dr_ * 2048 + (t).k0 + c_ * 16)); } \
        __syncthreads(); } while (0)
    f32x4 la[16], lb[16];
    int tile = blockIdx.x; if (tile >= NTILES) return;
    CvTile ta = cv_decode(F, tile), tb = ta; CV_LOAD(la, ta);
    for (;;) {
        const bool hb = tile + F.G < NTILES; if (hb) { tb = cv_decode(F, tile + F.G); CV_LOAD(lb, tb); }
        CV_PROC(la, ta); if (!hb) break; tile += F.G;
        const bool ha = tile + F.G < NTILES; if (ha) { ta = cv_decode(F, tile + F.G); CV_LOAD(la, ta); }
        CV_PROC(lb, tb); if (!ha) break; tile += F.G;
    }
#undef CV_LOAD
#undef CV_PROC
}

constexpr int NPH = 14;

__device__ __forceinline__ void p0_prologue(Frame& F) {
    const float* x = F.in[I_X]; const float* wmi = F.in[I_WMIXIN];
    LAS float* wf = (LAS float*)(F.lds + 73728);
    { f32x4 wl[4][2];
#pragma unroll
      for (int q = 0; q < 4; ++q) { const f32x4* p = (const f32x4*)(wmi + (size_t)(F.tid + 512 * q) * MIXIN + NPROJ); wl[q][0] = p[0]; wl[q][1] = p[1]; }
#pragma unroll
      for (int q = 0; q < 4; ++q) { const int d = F.tid + 512 * q;
#pragma unroll
          for (int hh = 0; hh < 8; ++hh) wf[hh * 2048 + d] = wl[q][hh >> 2][hh & 3]; } }
    __syncthreads();
    bf16* hbf = (bf16*)(F.ws + WS_HBF); float* logf = (float*)(F.ws + WS_LOGF);
    {
        const int lane = F.lane; const f32x4* gr = (const f32x4*)F.in[I_GMIX] + lane; float* rs0 = (float*)(F.ws + WS_RSTD2);
        f32x4 a[8], b[8], na[8], nb[8], gv[8];
#pragma unroll
        for (int j = 0; j < 8; ++j) gv[j] = gr[64 * j];
        const float bf_ = F.in[I_BFORGET][lane & 7];
#define P0_LOADP(A_, B_, m_) do { const int m1_ = (m_) + F.NGW < T ? (m_) + F.NGW : (m_); _Pragma("unroll") for (int j = 0; j < 8; ++j) { A_[j] = ((const f32x4*)(x + (size_t)(m_) * DM) + lane)[64 * j]; B_[j] = ((const f32x4*)(x + (size_t)m1_ * DM) + lane)[64 * j]; } } while (0)
        auto proc = [&](f32x4 (&a)[8], f32x4 (&b)[8], int m) __attribute__((always_inline)) {
            const bool two = m + F.NGW < T;
            float sa = 0.f, sb = 0.f;
#pragma unroll
            for (int j = 0; j < 8; ++j) { sa += (a[j].x * a[j].x + a[j].y * a[j].y) + (a[j].z * a[j].z + a[j].w * a[j].w); sb += (b[j].x * b[j].x + b[j].y * b[j].y) + (b[j].z * b[j].z + b[j].w * b[j].w); }
            const float qa = sqrtf(wave_sum(sa) * (1.f / 2048.f) + EPS), qb = sqrtf(wave_sum(sb) * (1.f / 2048.f) + EPS); const float ra = 1.f / qa, rb = 1.f / qb;
            if (lane == 0) { rs0[m] = qa; if (two) rs0[m + F.NGW] = qb; }
            v2u* oa = (v2u*)(hbf + (size_t)m * DM) + lane; v2u* ob = (v2u*)(hbf + (size_t)(m + F.NGW) * DM) + lane;
#pragma unroll
            for (int j = 0; j < 8; ++j) { const f32x4 g = gv[j]; a[j] = a[j] * ra * g; b[j] = b[j] * rb * g;
                v2u w; w.x = pk2(a[j].x, a[j].y); w.y = pk2(a[j].z, a[j].w); oa[64 * j] = w;
                if (two) { w.x = pk2(b[j].x, b[j].y); w.y = pk2(b[j].z, b[j].w); ob[64 * j] = w; } }
            float za = 0.f, zb = 0.f;
#pragma unroll 1
            for (int hh = 0; hh < 8; ++hh) { float s0 = 0.f, s1 = 0.f;
#pragma unroll
                for (int j = 0; j < 8; ++j) { const f32x4 w = *(const LAS f32x4*)(wf + hh * 2048 + 4 * (lane + 64 * j)); s0 += (a[j].x * w.x + a[j].y * w.y) + (a[j].z * w.z + a[j].w * w.w); s1 += (b[j].x * w.x + b[j].y * w.y) + (b[j].z * w.z + b[j].w * w.w); }
                s0 = wave_sum(s0); s1 = wave_sum(s1); za = (lane == hh) ? s0 : za; zb = (lane == hh) ? s1 : zb; }
            if (lane < 8) { logf[(size_t)m * 8 + lane] = log_sigmoid(za + bf_); if (two) logf[(size_t)(m + F.NGW) * 8 + lane] = log_sigmoid(zb + bf_); } };
        if (T == 8 * F.NGW) {
            const int m0 = F.gw, st = 2 * F.NGW;
            P0_LOADP(a, b, m0); P0_LOADP(na, nb, m0 + st); proc(a, b, m0); P0_LOADP(a, b, m0 + 2 * st); proc(na, nb, m0 + st); P0_LOADP(na, nb, m0 + 3 * st); proc(a, b, m0 + 2 * st); proc(na, nb, m0 + 3 * st);
        } else {
            for (int m = F.gw; m < T; m += 2 * F.NGW) { P0_LOADP(a, b, m); proc(a, b, m); }
        }
#undef P0_LOADP
    }
    {
        LAS float* scr = (LAS float*)(F.lds + F.wave * 8704);
        constexpr int IT_MI = 32 * 192;
        for (int r = F.gw; r < IT_MI; r += F.NGW) { const int n0 = 32 * (r % 192); int drow0 = n0;
            if (n0 >= 1024 && n0 < 3072) { const int ux = n0 >= 2048, c = n0 - (ux ? 2048 : 1024); drow0 = (4 + (c >> 7)) * 256 + ux * 128 + (c & 127); }
            transpose_item(F.in[I_WMIXIN], MIXIN, DM, 64 * (r / 192), n0, (bf16*)(F.ws + WS_WMIXIN), drow0, scr, F.lane, 64 * (r / 192), nullptr); }
    }
    { float* wrg = (float*)(F.ws + WS_WRG); const int gt = blockIdx.x * NTHREADS + F.tid;
      for (int i = gt; i < DM * NE; i += F.G * NTHREADS) wrg[i] = F.in[I_WROUTER][i] * F.in[I_GMOE][i >> 5]; }
}


__device__ __forceinline__ void late_work(Frame& F) {
    bf16* memn = (bf16*)(F.ws + WS_MEMN);
    for (int m = F.gw; m < MROWS; m += F.NGW) { f32x4 v[8]; rms_row_2048(F.in[I_MEM] + (size_t)m * DM, F.in[I_GMEM], memn + (size_t)m * DM, F.lane, v); }
    { const float* logf = (const float*)(F.ws + WS_LOGF); float* biasS = (float*)(F.ws + WS_BIAS); const int lane = F.lane;
    if (F.gw < BATCH * FH) {
        const int b = F.gw >> 3, h = F.gw & 7; float loc[32]; float run = 0.f;
#pragma unroll
        for (int i = 0; i < 32; ++i) { run += logf[((size_t)b * SEQ + lane * 32 + i) * 8 + h]; loc[i] = run; }
        float incl = run;
#pragma unroll
        for (int o = 1; o < 64; o <<= 1) { const float t = __shfl_up(incl, o); if (lane >= o) incl += t; }
        const float excl = incl - run;
#pragma unroll
        for (int i = 0; i < 32; ++i) biasS[(size_t)F.gw * SEQ + lane * 32 + i] = -(excl + loc[i]) * (1.f / ATT_SCALE);
    }
    }
    {   LAS float* scr = (LAS float*)(F.lds + F.wave * 8704);
        constexpr int IT_MO = 32 * 64, IT_XQ = 32 * 16, IT_XKV = 32 * 32, IT_XO = 8 * 64;
        constexpr int NITEMS = IT_MO + IT_XQ + IT_XKV + IT_XO;
        for (int it = F.gw; it < NITEMS; it += F.NGW) {
            int r = it;
            if (r < IT_MO) { const int k0 = 64 * (r / 64);
                transpose_item(F.in[I_WMIXOUT], DM, DM, k0, 32 * (r % 64), (bf16*)(F.ws + WS_WMIXOUT), 32 * (r % 64), scr, F.lane, (k0 + 1024) & 2047, k0 >= 1024 ? F.in[I_GFOX] + (k0 - 1024) : nullptr); continue; } r -= IT_MO;
            if (r < IT_XQ) { transpose_item(F.in[I_WXQ], XW, DM, 64 * (r / 16), 32 * (r % 16), (bf16*)(F.ws + WS_WXQ), 32 * (r % 16), scr, F.lane, 64 * (r / 16), F.in[I_GXATTN] + 64 * (r / 16)); continue; } r -= IT_XQ;
            if (r < IT_XKV) { transpose_item(F.in[I_WXKV], 1024, DM, 64 * (r / 32), 32 * (r % 32), (bf16*)(F.ws + WS_WXKV), 32 * (r % 32), scr, F.lane, 64 * (r / 32), nullptr); continue; } r -= IT_XKV;
            { transpose_item(F.in[I_WXO], DM, XW, 64 * (r / 64), 32 * (r % 64), (bf16*)(F.ws + WS_WXO), 32 * (r % 64), scr, F.lane, 64 * (r / 64), nullptr); }
        }
    }
    __syncthreads();
    p0_moe_convert8(F);
    __syncthreads();
}

struct P2Row { v4u ub[2], c0[2], c1[2], c2[2]; float m1, m2; };
__device__ __forceinline__ void p2_load(P2Row& R, const bf16* proj, int t, int lane) {
    const bf16* pr = proj + (size_t)t * NPROJ; const int s = t & (SEQ - 1), ch = lane * 16;
    const bf16* pr1 = (s >= 1) ? pr - NPROJ : pr; const bf16* pr2 = (s >= 2) ? pr - 2 * NPROJ : pr;
    R.m1 = (s >= 1) ? 1.f : 0.f; R.m2 = (s >= 2) ? 1.f : 0.f;
#pragma unroll
    for (int hb = 0; hb < 2; ++hb) { const int c = ch + hb * 8;
        R.ub[hb] = *(const v4u*)(pr + c); R.c0[hb] = *(const v4u*)(pr + 1024 + c); R.c1[hb] = *(const v4u*)(pr1 + 1024 + c); R.c2[hb] = *(const v4u*)(pr2 + 1024 + c); }
}
__device__ __forceinline__ void p2_finish(const P2Row& R, const float (&cw)[3][16], const float (&gconv)[16], bf16* ymix, int t, int lane) {
    const int ch = lane * 16; float y[16]; float ss = 0.f;
#pragma unroll
    for (int hb = 0; hb < 2; ++hb) { float ub[8], a[8], a1[8], a0[8];
        unpack8(R.ub[hb], ub); unpack8(R.c0[hb], a); unpack8(R.c1[hb], a1); unpack8(R.c2[hb], a0);
#pragma unroll
        for (int i = 0; i < 8; ++i) { const float v = ub[i] * (cw[0][hb * 8 + i] * R.m2 * a0[i] + cw[1][hb * 8 + i] * R.m1 * a1[i] + cw[2][hb * 8 + i] * a[i]); y[hb * 8 + i] = v; ss += v * v; } }
    const float rstd = 1.f / sqrtf(wave_sum(ss) * (1.f / 1024.f) + EPS);
#pragma unroll
    for (int hb = 0; hb < 2; ++hb) { float o[8];
#pragma unroll
        for (int i = 0; i < 8; ++i) o[i] = y[hb * 8 + i] * rstd * gconv[hb * 8 + i];
        *(v4u*)(ymix + (size_t)t * DM + 1024 + ch + hb * 8) = pack8(o); }
}
__device__ __forceinline__ void p2_tokens(Frame& F) {
    const bf16* proj = (const bf16*)(F.ws + WS_PROJ); bf16* ymix = (bf16*)(F.ws + WS_YMIX);
    float cw[3][16], gc[16];
#pragma unroll
    for (int q = 0; q < 4; ++q) { const f32x4 g4 = *(const f32x4*)(F.in[I_GCONV] + F.lane * 16 + 4 * q); gc[4 * q] = g4[0]; gc[4 * q + 1] = g4[1]; gc[4 * q + 2] = g4[2]; gc[4 * q + 3] = g4[3];
#pragma unroll
        for (int k = 0; k < 3; ++k) { const f32x4 w4 = *(const f32x4*)(F.in[I_CONVW] + k * 1024 + F.lane * 16 + 4 * q); cw[k][4 * q] = w4[0]; cw[k][4 * q + 1] = w4[1]; cw[k][4 * q + 2] = w4[2]; cw[k][4 * q + 3] = w4[3]; } }
    for (int t = F.gw; t < T; t += 2 * F.NGW) {
        P2Row R0, R1; const bool two = t + F.NGW < T;
        p2_load(R0, proj, t, F.lane); if (two) p2_load(R1, proj, t + F.NGW, F.lane);
        p2_finish(R0, cw, gc, ymix, t, F.lane); if (two) p2_finish(R1, cw, gc, ymix, t + F.NGW, F.lane);
    }
}

__device__ __forceinline__ void p11_router(Frame& F) {
    LAS float* rs = (LAS float*)F.lds;
    LAS float* part = rs + 64;
    LAS int* hist = (LAS int*)(part + 4 * 64 * 33);
    const bf16* x2 = (const bf16*)(F.ws + WS_HBF); const float* wrg = (const float*)(F.ws + WS_WRG); const float* ss2 = (const float*)(F.ws + WS_SS2); float* rstd2 = (float*)(F.ws + WS_RSTD2);
    int* topi = (int*)(F.ws + WS_TOPI); float* topg = (float*)(F.ws + WS_TOPG);
    const int lane = F.lane, wv = F.wave;
    for (int tile = blockIdx.x; tile < T / 64; tile += F.G) {
        const int t0 = tile * 64;
        if (F.tid < 32) hist[F.tid] = 0;
        if (wv == 1) { const f32x4* p4 = (const f32x4*)(ss2 + (size_t)(t0 + lane) * 32); f32x4 a = p4[0];
#pragma unroll
            for (int j = 1; j < 8; ++j) a += p4[j];
            const float rstd = 1.f / sqrtf(((a[0] + a[1]) + (a[2] + a[3])) * (1.f / 2048.f) + EPS); rs[lane] = rstd; rstd2[t0 + lane] = rstd; }
        { const int th = wv >> 2, kq = wv & 3, i = lane & 31, half = lane >> 5;
          f32x16 acc = {};
          const bf16* xrow = x2 + (size_t)(t0 + th * 32 + i) * DM + kq * 512 + 4 * half;
          const float* wb = wrg + (size_t)(kq * 512 + 4 * half) * 32 + i;
#define RT_LOAD(A_, B_, s0_) do { _Pragma("unroll") for (int u_ = 0; u_ < 4; ++u_) { { const v2u w_ = *(const v2u*)(xrow + 8 * ((s0_) + u_)); A_[u_] = (f32x4){lo16(w_.x), hi16(w_.x), lo16(w_.y), hi16(w_.y)}; } \
              _Pragma("unroll") for (int e_ = 0; e_ < 4; ++e_) B_[u_][e_] = wb[(8 * ((s0_) + u_) + e_) * 32]; } } while (0)
#define RT_MMA(A_, B_) do { _Pragma("unroll") for (int u_ = 0; u_ < 4; ++u_) { acc = __builtin_amdgcn_mfma_f32_32x32x2f32(A_[u_].x, B_[u_][0], acc, 0, 0, 0); acc = __builtin_amdgcn_mfma_f32_32x32x2f32(A_[u_].y, B_[u_][1], acc, 0, 0, 0); \
              acc = __builtin_amdgcn_mfma_f32_32x32x2f32(A_[u_].z, B_[u_][2], acc, 0, 0, 0); acc = __builtin_amdgcn_mfma_f32_32x32x2f32(A_[u_].w, B_[u_][3], acc, 0, 0, 0); } } while (0)
          f32x4 a0[4], a1[4]; float b0[4][4], b1[4][4];
          RT_LOAD(a0, b0, 0);
#pragma unroll 1
          for (int s8 = 0; s8 < 64; s8 += 8) { RT_LOAD(a1, b1, s8 + 4); RT_MMA(a0, b0); if (s8 + 8 < 64) RT_LOAD(a0, b0, s8 + 8); RT_MMA(a1, b1); }
#undef RT_LOAD
#undef RT_MMA
#pragma unroll
          for (int r = 0; r < 16; ++r) { const int row = (r & 3) + 8 * (r >> 2) + 4 * half; part[(kq * 64 + th * 32 + row) * 33 + i] = acc[r]; }
        }
        __syncthreads();
        if (F.tid < 64) {
            const int tk = F.tid; const float rstd = rs[tk]; float lg[32];
#pragma unroll
            for (int e = 0; e < 32; ++e) lg[e] = (part[(0 * 64 + tk) * 33 + e] + part[(1 * 64 + tk) * 33 + e] + part[(2 * 64 + tk) * 33 + e] + part[(3 * 64 + tk) * 33 + e]) * rstd + F.in[I_BROUTER][e];
            float tv[4]; int ti[4];
#pragma unroll
            for (int k = 0; k < 4; ++k) { float best = -3.0e38f; int bi = 0;
#pragma unroll
                for (int e = 0; e < 32; ++e) { const bool taken = (k > 0 && ti[0] == e) || (k > 1 && ti[1] == e) || (k > 2 && ti[2] == e); if (!taken && lg[e] > best) { best = lg[e]; bi = e; } }
                tv[k] = best; ti[k] = bi; }
            const float e1 = expf(tv[1] - tv[0]), e2 = expf(tv[2] - tv[0]), e3 = expf(tv[3] - tv[0]); const float inv = 1.f / (1.f + e1 + e2 + e3);
            const float gg[4] = {inv, e1 * inv, e2 * inv, e3 * inv};
#pragma unroll
            for (int k = 0; k < 4; ++k) { topi[(size_t)(t0 + tk) * 4 + k] = ti[k]; topg[(size_t)(t0 + tk) * 4 + k] = gg[k]; atomicAdd((int*)&hist[ti[k]], 1); }
        }
        __syncthreads();
        if (F.tid < 32) atomicAdd(F.ctl + CW_COUNTS + 64 * F.tid, (unsigned)hist[F.tid]);
        __syncthreads();
    }
}

__device__ __forceinline__ void expert_bases(Frame& F, LAS int* base, LAS int* cnt) {
    if (F.tid < 32) cnt[F.tid] = (int)__hip_atomic_load(F.ctl + CW_COUNTS + 64 * F.tid, __ATOMIC_RELAXED, __HIP_MEMORY_SCOPE_AGENT);
    __syncthreads();
    if (F.tid == 0) { int run = 0; for (int e = 0; e < 32; ++e) { base[e] = run; run += (cnt[e] + 255) & ~255; } base[32] = run; }
    __syncthreads();
}

__device__ __forceinline__ void p12_lists(Frame& F) {
    LAS int* base = (LAS int*)F.lds; LAS int* cnt = base + 40; LAS int* hist = cnt + 32; LAS int* wgb = hist + 32;
    const int* topi = (const int*)(F.ws + WS_TOPI); int* pos = (int*)(F.ws + WS_POS); int* list = (int*)(F.ws + WS_LIST); const float* rstd2 = (const float*)(F.ws + WS_RSTD2); float* rss = (float*)(F.ws + WS_RSS);
    expert_bases(F, base, cnt);
    for (int tile = blockIdx.x; tile < T / 64; tile += F.G) {
        if (F.tid < 32) hist[F.tid] = 0;
        __syncthreads();
        int e = 0, r = 0;
        if (F.tid < 256) { e = topi[(size_t)tile * 256 + F.tid]; r = atomicAdd((int*)&hist[e], 1); }
        __syncthreads();
        if (F.tid < 32) wgb[F.tid] = (int)atomicAdd(F.ctl + CW_CURSOR + 64 * F.tid, (unsigned)hist[F.tid]);
        __syncthreads();
        if (F.tid < 256) { const int p = base[e] + wgb[e] + r; pos[(size_t)tile * 256 + F.tid] = p; list[p] = tile * 64 + (F.tid >> 2); rss[p] = rstd2[tile * 64 + (F.tid >> 2)]; }
        __syncthreads();
    }
    if (blockIdx.x == 0 && F.tid < 32) { for (int p = base[F.tid] + cnt[F.tid]; p < base[F.tid + 1]; ++p) { list[p] = 0; rss[p] = 1.f; } }
}

__device__ __forceinline__ void p15_combine(Frame& F) {
    const int* pos = (const int*)(F.ws + WS_POS); const float* topg = (const float*)(F.ws + WS_TOPG); const unsigned char* Y = F.ws + WS_Y; const bf16* X2 = (const bf16*)(F.ws + WS_HBF); const int lane = F.lane;
    int t = F.gw; if (t >= T) return;
    int pk[4]; float gk[4];
#pragma unroll
    for (int k = 0; k < 4; ++k) { pk[k] = pos[(size_t)t * 4 + k]; gk[k] = topg[(size_t)t * 4 + k]; }
    for (;;) {
        const int tn = t + F.NGW; const bool more = tn < T; const int tq = more ? tn : t;
        int pn[4]; float gn[4];
#pragma unroll
        for (int k = 0; k < 4; ++k) { pn[k] = pos[(size_t)tq * 4 + k]; gn[k] = topg[(size_t)tq * 4 + k]; }
        float* orow = F.out + (size_t)t * DM;
        v4u xw[4]; v2u yw[4][4];
#pragma unroll
        for (int j = 0; j < 4; ++j) { const int c = (lane + 64 * j) * 8; xw[j] = __builtin_nontemporal_load((const v4u*)(X2 + (size_t)t * DM + c));
#pragma unroll
            for (int k = 0; k < 4; ++k) yw[j][k] = __builtin_nontemporal_load((const v2u*)(Y + (size_t)pk[k] * DM + c)); }
#pragma unroll
        for (int j = 0; j < 4; ++j) { const int c = (lane + 64 * j) * 8; float xf[8]; unpack8(xw[j], xf); f32x4 a = {xf[0], xf[1], xf[2], xf[3]}, b = {xf[4], xf[5], xf[6], xf[7]};
#pragma unroll
            for (int k = 0; k < 4; ++k) { const float g = gk[k] * pg8::Y8_INV; const auto f01 = __builtin_amdgcn_cvt_pk_f32_fp8((int)yw[j][k].x, false), f23 = __builtin_amdgcn_cvt_pk_f32_fp8((int)yw[j][k].x, true), f45 = __builtin_amdgcn_cvt_pk_f32_fp8((int)yw[j][k].y, false), f67 = __builtin_amdgcn_cvt_pk_f32_fp8((int)yw[j][k].y, true);
                a.x += g * f01[0]; a.y += g * f01[1]; a.z += g * f23[0]; a.w += g * f23[1]; b.x += g * f45[0]; b.y += g * f45[1]; b.z += g * f67[0]; b.w += g * f67[1]; }
            __builtin_nontemporal_store(a, (f32x4*)(orow + c)); __builtin_nontemporal_store(b, (f32x4*)(orow + c + 4)); }
        if (!more) break;
        t = tn;
#pragma unroll
        for (int k = 0; k < 4; ++k) { pk[k] = pn[k]; gk[k] = gn[k]; }
    }
}

__global__ void __launch_bounds__(NTHREADS, 2) fwd(Args args) {
    extern __shared__ __attribute__((aligned(16))) unsigned char lds[];
    Frame F;
    F.lds = (LAS unsigned char*)lds; F.tid = threadIdx.x; F.lane = F.tid & 63; F.wave = __builtin_amdgcn_readfirstlane(F.tid >> 6);
    F.G = gridDim.x; { const int bx = blockIdx.x; F.vcu = (F.G % 8 == 0) ? (bx % 8) * (F.G / 8) + bx / 8 : bx; }
    F.gw = F.vcu * NWAVES + F.wave; F.NGW = F.G * NWAVES;
    F.in = args.in; F.out = args.out; F.ws = args.ws; F.ctl = (unsigned*)(args.ws + WS_CTL);
    const int lo = args.ph_lo, hi = args.ph_hi;
    volatile LAS unsigned* MISC = (volatile LAS unsigned*)(F.lds + MISC_OFF);
    if (F.tid < 32) MISC[F.tid] = 0u;
    __syncthreads();
#define SEAM(k) do { if (IN(k) && IN((k) + 1)) { xcd_barrier_nb((unsigned*)(args.ws + WS_CTL) + CW_BAR, xb_xcc_id(), (volatile LAS unsigned*)((LAS unsigned char*)lds + MISC_OFF) + 8); } } while (0)
#ifndef ONLY
#define ONLY -1
#endif
#define IN(k) ((ONLY < 0 || ONLY == (k)) && lo <= (k) && (k) < hi)
    unsigned char* ws = args.ws;
    bf16* hbf = (bf16*)(ws + WS_HBF); bf16* proj = (bf16*)(ws + WS_PROJ); bf16* ymix = (bf16*)(ws + WS_YMIX);

    if (IN(0)) { p0_prologue(F); }
    if (hi - lo > 1) (void)xcd_barrier_post((unsigned*)(args.ws + WS_CTL) + CW_BAR, (volatile LAS unsigned*)((LAS unsigned char*)lds + MISC_OFF) + 8);
    SEAM(0);
    if (IN(1)) { pg8::DenseOrder S; S.init(hbf, ws + WS_WMIXIN, T, NPROJ, DM, F.G, (int)blockIdx.x);
                 const bool conv_first = (F.vcu & 1) == 0;
                 if (conv_first) late_work(F);
                 pg8::gemm_phase<pg8::EpiProj, pg8::DenseOrder, false, true>(F.lds, DM, S, pg8::EpiProj{proj, F.in[I_GQ], F.in[I_GK], (LAS float*)(F.lds + RSS_OFF)});
                 if (!conv_first) late_work(F); }
    SEAM(1);
    if (IN(3)) {
        const bool p2_first = (F.vcu & 1) == 0;
        if (p2_first) p2_tokens(F);
        const float* biasS = (const float*)(ws + WS_BIAS); char* L = (char*)lds; float* ssf = (float*)(ws + WS_SSF);
        constexpr int W = 1 << 20; const int total = BATCH * FH * 4;
        int cur_bh = -1; bool primed = false; fa::Seam S;
        auto ref = [&](int item, int pass) { const int bh = item >> 2, x = item & 3, qb = pass ? 7 - x : x, b = bh >> 3, h = bh & 7; const size_t t0 = (size_t)b * SEQ + qb * 256;
            fa::BlockRef r; r.Q = proj + t0 * NPROJ + 3072 + h * HD; r.K = proj + (size_t)b * SEQ * NPROJ + 4096 + h * HD; r.V = r.K + 1024; r.O = ymix + t0 * DM + h * HD; r.P0 = qb * 256; return r; };
        for (int item = blockIdx.x; item < total; item += F.G) {
            const int bh = item >> 2;
            if (bh != cur_bh) { __syncthreads(); *(f32x4*)(L + fa::BIAS_OFF + F.tid * 16) = *(const f32x4*)(biasS + (size_t)bh * SEQ + F.tid * 4); cur_bh = bh; __syncthreads(); }
            fa::BlockRef c0 = ref(item, 0), c1 = ref(item, 1);
            if (!primed) { fa::prime<NPROJ, NPROJ>(c0, W, L, S); primed = true; }
            const bool more = item + F.G < total; fa::BlockRef nx = more ? ref(item + F.G, 0) : c1;
            fa::block<NPROJ, NPROJ, DM, true, true, true>(c0, c1, SEQ, W, L, S, ymix, ssf);
            fa::block<NPROJ, NPROJ, DM, true, true, true>(c1, nx, SEQ, W, L, S, ymix, ssf);
        }
        asm volatile("s_waitcnt vmcnt(0)" ::: "memory"); __syncthreads();
        if (!p2_first) p2_tokens(F);
    }
    SEAM(3);
    if (IN(4)) { pg8::DenseOrder S; S.init(ymix, ws + WS_WMIXOUT, T, DM, DM, F.G, (int)blockIdx.x);
                 LAS float* rl = (LAS float*)(F.lds + RSS_OFF); const float* ssf = (const float*)(ws + WS_SSF);
                 { pg8::Unit u; for (int i = 0; i < RSS_UNITS && S.next(i, u); ++i) if (F.tid < 256) { const f32x4 s0 = *(const f32x4*)(ssf + (size_t)(u.pm * 256 + F.tid) * 8), s1 = *(const f32x4*)(ssf + (size_t)(u.pm * 256 + F.tid) * 8 + 4);
                       rl[i * 256 + F.tid] = 1.f / sqrtf(((s0[0] + s0[1]) + (s0[2] + s0[3]) + (s1[0] + s1[1]) + (s1[2] + s1[3])) * (1.f / 1024.f) + EPS); } }
                 __syncthreads();
                 pg8::gemm_phase<pg8::EpiRes1, pg8::DenseOrder, false, true, true>(F.lds, DM, S, pg8::EpiRes1{(const float*)(ws + WS_RSTD2), F.in[I_GMIX], hbf, (float*)(ws + WS_SS1), ssf, rl}); }
    SEAM(4);
    if (IN(5)) { pg8::DualOrder S{128, 2, 32, 4, 64, F.G, (int)blockIdx.x, (const char*)hbf, (const char*)(ws + WS_WXQ), (const char*)(ws + WS_MEMN), (const char*)(ws + WS_WXKV), (size_t)256 * DM * 2};
                 pg8::gemm_phase<pg8::EpiXProj, pg8::DualOrder, false, true>(F.lds, DM, S, pg8::EpiXProj{(bf16*)(ws + WS_QX), (bf16*)(ws + WS_KVX), F.in[I_GXQ], F.in[I_GXK], (const float*)(ws + WS_SS1), (LAS float*)(F.lds + RSS_OFF)}); }
    SEAM(5);
    if (IN(7)) {
        const bf16* qx = (const bf16*)(ws + WS_QX); const bf16* kvx = (const bf16*)(ws + WS_KVX); bf16* ox = (bf16*)(ws + WS_OX); char* L = (char*)lds;
        constexpr int W = 1 << 20; const int total = BATCH * XH * 8;
        bool primed = false; fa::Seam S;
        auto ref = [&](int item) { const int qb = item & 7, h = (item >> 3) & 3, b = item >> 5; const size_t t0 = (size_t)b * SEQ + qb * 256;
            fa::BlockRef r; r.Q = qx + t0 * XW + h * HD; r.K = kvx + (size_t)b * MEMT * 1024 + h * HD; r.V = r.K + 512; r.O = ox + t0 * XW + h * HD; r.P0 = 256; return r; };
        for (int item = blockIdx.x; item < total; item += F.G) {
            fa::BlockRef c0 = ref(item);
            if (!primed) { fa::prime<XW, 1024>(c0, W, L, S); primed = true; }
            const bool more = item + F.G < total; fa::BlockRef nx = more ? ref(item + F.G) : c0;
            fa::block<XW, 1024, XW, false, false, false>(c0, nx, MEMT, W, L, S);
        }
        asm volatile("s_waitcnt vmcnt(0)" ::: "memory"); __syncthreads();
    }
    SEAM(7);
    if (IN(8)) { pg8::DenseOrder S; S.init(ws + WS_OX, ws + WS_WXO, T, DM, XW, F.G, (int)blockIdx.x);
                 pg8::gemm_phase<pg8::EpiRes2, pg8::DenseOrder, false, true>(F.lds, XW, S, pg8::EpiRes2{hbf, (float*)(ws + WS_SS2), ws + WS_X2N8, F.in[I_GMOE]}); }
    SEAM(8);
    if (IN(9)) { p11_router(F); }
    SEAM(9);
    if (IN(10)) { p12_lists(F); }
    SEAM(10);
    if (IN(11) || IN(12)) {
        LAS int* base = (LAS int*)(F.lds + TABLE_OFF); LAS int* cnt = base + 40; LAS short* tile_e = (LAS short*)(cnt + 32);
        expert_bases(F, base, cnt);
        const int ntile = base[32] / 256; const int* list = (const int*)(ws + WS_LIST);
        for (int pm = F.tid; pm < ntile; pm += NTHREADS) { int e = 0; while (base[e + 1] <= pm * 256) ++e; tile_e[pm] = (short)e; }
        __syncthreads();
        if (IN(11)) { pg8::MoeOrder S{ntile * 16, 16, F.G, F.vcu, (const char*)(ws + WS_X2N8), (const char*)(ws + WS_WGU), (size_t)4096 * DM, (size_t)256 * DM, tile_e, list, true};
            LAS float* rl = (LAS float*)(F.lds + RSS_OFF);
            { pg8::Unit u; for (int i = 0; i < RSS_UNITS && S.next(i, u); ++i) if (F.tid < 256) rl[i * 256 + F.tid] = ((const float*)(ws + WS_RSS))[u.pm * 256 + F.tid]; }
            __syncthreads();
            pg8::gemm_phase8<pg8::EpiGlu8, pg8::MoeOrder, true, true>(F.lds, DM, S, pg8::EpiGlu8{(unsigned char*)(ws + WS_GLU), F.in[I_BGU], tile_e, (const float*)(ws + WS_RSS), rl}); }
        SEAM(11);
        if (IN(12)) { pg8::MoeOrder S{ntile * 8, 8, F.G, F.vcu, (const char*)(ws + WS_GLU), (const char*)(ws + WS_WDN), (size_t)DM * DFF, (size_t)256 * DFF, tile_e, list, false};
            pg8::gemm_phase8<pg8::EpiBiasFp8, pg8::MoeOrder, false, true>(F.lds, DFF, S, pg8::EpiBiasFp8{ws + WS_Y, F.in[I_BDN], tile_e}); }
    }
    SEAM(12);
    if (IN(13)) { p15_combine(F); }
#undef IN
}

extern "C" void kernel_launch(void* const* d_in, const int* in_sizes, int n_in, void* d_out, int out_size, void* d_ws, size_t ws_size, hipStream_t stream) {
    static int grid = 0;
    if (grid == 0) {
        if (n_in != 25 || out_size != T * DM || ws_size < WS_END) { fprintf(stderr, "kernel_launch: unexpected shapes (n_in %d out %d ws %zu need %zu)\n", n_in, out_size, ws_size, (size_t)WS_END); grid = -1; return; }
        int dev = 0, cus = 0;
        if (hipGetDevice(&dev) != hipSuccess || hipDeviceGetAttribute(&cus, hipDeviceAttributeMultiprocessorCount, dev) != hipSuccess) { grid = -1; return; }
        if (hipFuncSetAttribute((const void*)fwd, hipFuncAttributeMaxDynamicSharedMemorySize, LDS_BYTES) != hipSuccess) { fprintf(stderr, "kernel_launch: hipFuncSetAttribute failed\n"); grid = -1; return; }
        if (cus < 192) { fprintf(stderr, "kernel_launch: %d CUs: the per-workgroup LDS caches assume at least 192\n", cus); grid = -1; return; }
        grid = cus;
    }
    if (grid < 0) return;
    (void)hipMemsetAsync((char*)d_ws + WS_CTL, 0, CTL_ZERO_BYTES, stream);
    Args a{};
    for (int i = 0; i < 25; ++i) a.in[i] = (const float*)d_in[i];
    a.out = (float*)d_out; a.ws = (unsigned char*)d_ws;
#if ONE_LAUNCH
    a.ph_lo = 0; a.ph_hi = NPH; hipLaunchKernelGGL(fwd, dim3(grid), dim3(NTHREADS), LDS_BYTES, stream, a);
#ifdef EXTRA_PHASES
    { const int extra[] = {EXTRA_PHASES}; a.out = (float*)((unsigned char*)d_ws + WS_END);     for (int ph : extra) { a.ph_lo = ph; a.ph_hi = ph + 1; hipLaunchKernelGGL(fwd, dim3(grid), dim3(NTHREADS), LDS_BYTES, stream, a); } }
#endif
#else
    for (int ph = 0; ph < NPH; ++ph) { a.ph_lo = ph; a.ph_hi = ph + 1; hipLaunchKernelGGL(fwd, dim3(grid), dim3(NTHREADS), LDS_BYTES, stream, a); }
#endif
}
```
